# Optimizing an MI355X kernel written in HIP

```python
import jax
import jax.numpy as jnp
from jax import lax
import numpy as np

D_MODEL = 2048
BATCH = 1
SEQ = 8192
DEPTH = 2
DEC_BATCH = 4
DEC_SEQ = 8192
PAST_LEN = 128

MIX_WIDTH = D_MODEL
GROUP_WIDTH = MIX_WIDTH // 4
FNET_GROUPS = 4
FNET_GROUP_DIM = GROUP_WIDTH // FNET_GROUPS
GLA_HEADS = 4
GLA_DK = GROUP_WIDTH // (2 * GLA_HEADS)
GLA_DV = GROUP_WIDTH // GLA_HEADS
GLA_RANK = 16
GLA_TAU = 16.0
GLA_CHUNK = 64
LRU_WIDTH = GROUP_WIDTH
LRU_BLOCKS = 8
LRU_BLOCK_DIM = LRU_WIDTH // LRU_BLOCKS
LRU_C = 8.0
LRU_TAPS = 4
CONF_WIDTH = GROUP_WIDTH
CONF_TAPS = 31
D_FF = 5632
N_SUB = 3
EPS = 1e-6
MIX_IN_SIZES = (GROUP_WIDTH, GLA_HEADS * GLA_DK, GLA_HEADS * GLA_DK, GLA_HEADS * GLA_DV, GLA_HEADS * GLA_DV, 2 * GLA_RANK, LRU_WIDTH, LRU_WIDTH, 2 * CONF_WIDTH)
MIX_IN_WIDTH = sum(MIX_IN_SIZES)

kernel_name = 'hybrid_bidir_encoder_two_groups'


def rms_norm(x, g):
    xf = x.astype(jnp.float32)
    y = xf * lax.rsqrt(jnp.mean(xf * xf, axis=-1, keepdims=True) + EPS)
    return (y * g.astype(jnp.float32)).astype(x.dtype)


def layer_norm(x, g, b):
    xf = x.astype(jnp.float32)
    xc = xf - jnp.mean(xf, axis=-1, keepdims=True)
    y = xc * lax.rsqrt(jnp.mean(xc * xc, axis=-1, keepdims=True) + EPS)
    return (y * g.astype(jnp.float32) + b.astype(jnp.float32)).astype(x.dtype)


def depthwise_conv(x, w, pad_left, pad_right):
    return lax.conv_general_dilated(
        x, w[:, None, :].astype(x.dtype), window_strides=(1,),
        padding=[(pad_left, pad_right)],
        dimension_numbers=('NWC', 'WIO', 'NWC'),
        feature_group_count=x.shape[-1])


def swiglu(h, w_in, w_out):
    up, gate = jnp.split(h @ w_in, 2, axis=-1)
    return (jax.nn.silu(gate) * up) @ w_out


def flip(t):
    return jnp.flip(t, axis=1)


def fourier_mix(u):
    B, S, _ = u.shape
    uf = u.astype(jnp.float32).reshape(B, S, FNET_GROUPS, FNET_GROUP_DIM)
    y = jnp.fft.fft2(uf, axes=(1, 3), norm='ortho').real
    return y.reshape(B, S, GROUP_WIDTH).astype(u.dtype)


def gla_scan(q, k, v, log_a):
    B, S, H, DK = q.shape
    DV = v.shape[-1]
    n = S // GLA_CHUNK

    def to_chunks(t):
        return t.astype(jnp.float32).reshape(B, n, GLA_CHUNK, H, t.shape[-1]).transpose(1, 0, 3, 2, 4)

    qc, kc, vc, gc = to_chunks(q), to_chunks(k), to_chunks(v), to_chunks(log_a)
    mask = jnp.tril(jnp.ones((GLA_CHUNK, GLA_CHUNK), dtype=bool))[:, :, None]

    def step(state, inp):
        qi, ki, vi, gi = inp
        b = jnp.cumsum(gi, axis=2)
        o_inter = jnp.einsum('bhtk,bhkv->bhtv', qi * jnp.exp(b), state)
        diff = b[:, :, :, None, :] - b[:, :, None, :, :]
        decay = jnp.exp(jnp.where(mask, diff, -jnp.inf))
        scores = jnp.einsum('bhtk,bhsk,bhtsk->bhts', qi, ki, decay)
        o_intra = jnp.einsum('bhts,bhsv->bhtv', scores, vi)
        b_last = b[:, :, -1:, :]
        new_state = jnp.exp(b_last[:, :, 0, :])[..., None] * state + jnp.einsum(
            'bhsk,bhsv->bhkv', ki * jnp.exp(b_last - b), vi)
        return new_state, o_inter + o_intra

    state0 = jnp.zeros((B, H, DK, DV), jnp.float32)
    _, out = lax.scan(step, state0, (qc, kc, vc, gc))
    return out.transpose(1, 0, 3, 2, 4).reshape(B, S, H, DV)


def rglru_direction(x, conv_w, conv_b, w_a, b_a, w_x, b_x, lam):
    B, S, W = x.shape
    xc = depthwise_conv(x, conv_w, LRU_TAPS - 1, 0) + conv_b
    xb = xc.reshape(B, S, LRU_BLOCKS, LRU_BLOCK_DIM)
    r = jax.nn.sigmoid((jnp.einsum('bsni,nij->bsnj', xb, w_a).reshape(B, S, W) + b_a).astype(jnp.float32))
    i = jax.nn.sigmoid((jnp.einsum('bsni,nij->bsnj', xb, w_x).reshape(B, S, W) + b_x).astype(jnp.float32))
    log_a = -LRU_C * r * jax.nn.softplus(-lam.astype(jnp.float32))
    a = jnp.exp(log_a)
    u = jnp.sqrt(-jnp.expm1(2.0 * log_a)) * (i * xc.astype(jnp.float32))

    def combine(left, right):
        a_l, h_l = left
        a_r, h_r = right
        return a_l * a_r, a_r * h_l + h_r

    _, hs = lax.associative_scan(combine, (a, u), axis=1)
    return hs.astype(x.dtype)


def hybrid_mixer(h, w_mix_in, gla_w_alpha, gla_b_alpha, gla_norm_g,
                 lru_conv_w, lru_conv_b, lru_w_a, lru_b_a, lru_w_x, lru_b_x, lru_lambda,
                 conf_dw_w, conf_dw_b, conf_ln_g, conf_ln_b, w_mix_out):
    B, S, _ = h.shape
    offsets = [sum(MIX_IN_SIZES[:j + 1]) for j in range(len(MIX_IN_SIZES) - 1)]
    f_in, q, k, v, o_gate, a_lr, r_in, r_gate, c_in = jnp.split(h @ w_mix_in, offsets, axis=-1)

    y_f = fourier_mix(f_in)

    q = q.reshape(B, S, GLA_HEADS, GLA_DK) * (GLA_DK ** -0.5)
    k = k.reshape(B, S, GLA_HEADS, GLA_DK)
    v = v.reshape(B, S, GLA_HEADS, GLA_DV)
    z = jnp.einsum('bsdr,drk->bsdk', a_lr.reshape(B, S, 2, GLA_RANK), gla_w_alpha) + gla_b_alpha
    log_a = (jax.nn.log_sigmoid(z.astype(jnp.float32)) / GLA_TAU).reshape(B, S, 2, GLA_HEADS, GLA_DK)
    o_fwd = gla_scan(q, k, v, log_a[:, :, 0])
    o_bwd = flip(gla_scan(flip(q), flip(k), flip(v), flip(log_a[:, :, 1])))
    o = rms_norm((o_fwd + o_bwd).astype(h.dtype), gla_norm_g) * jax.nn.silu(o_gate.reshape(B, S, GLA_HEADS, GLA_DV))
    y_g = o.reshape(B, S, GROUP_WIDTH)

    h_fwd = rglru_direction(r_in, lru_conv_w[0], lru_conv_b[0], lru_w_a[0], lru_b_a[0],
                            lru_w_x[0], lru_b_x[0], lru_lambda[0])
    h_bwd = flip(rglru_direction(flip(r_in), lru_conv_w[1], lru_conv_b[1], lru_w_a[1], lru_b_a[1],
                                 lru_w_x[1], lru_b_x[1], lru_lambda[1]))
    y_r = (h_fwd + h_bwd) * jax.nn.gelu(r_gate)

    c_val, c_g = jnp.split(c_in, 2, axis=-1)
    u = c_val * jax.nn.sigmoid(c_g)
    u = depthwise_conv(u, conf_dw_w, CONF_TAPS // 2, CONF_TAPS // 2) + conf_dw_b
    y_c = jax.nn.silu(layer_norm(u, conf_ln_g, conf_ln_b))

    return jnp.concatenate([y_f, y_g, y_r, y_c], axis=-1) @ w_mix_out


def encoder_layer(x, c, w_ada, b_ada, g_pre, g_post, ffn1_w_in, ffn1_w_out, ffn2_w_in, ffn2_w_out,
                  w_mix_in, gla_w_alpha, gla_b_alpha, gla_norm_g,
                  lru_conv_w, lru_conv_b, lru_w_a, lru_b_a, lru_w_x, lru_b_x, lru_lambda,
                  conf_dw_w, conf_dw_b, conf_ln_g, conf_ln_b, w_mix_out):
    B = x.shape[0]
    mod = (jax.nn.silu(c) @ w_ada + b_ada).reshape(B, N_SUB, 3, D_MODEL)[:, :, :, None, :]

    def pre(t, j):
        return rms_norm(t, g_pre[j]) * (1.0 + mod[:, j, 1]) + mod[:, j, 0]

    def post(t, out, j, w):
        return t + w * mod[:, j, 2] * rms_norm(out, g_post[j])

    x = post(x, swiglu(pre(x, 0), ffn1_w_in, ffn1_w_out), 0, 0.5)
    x = post(x, hybrid_mixer(pre(x, 1), w_mix_in, gla_w_alpha, gla_b_alpha, gla_norm_g,
                             lru_conv_w, lru_conv_b, lru_w_a, lru_b_a, lru_w_x, lru_b_x, lru_lambda,
                             conf_dw_w, conf_dw_b, conf_ln_g, conf_ln_b, w_mix_out), 1, 1.0)
    x = post(x, swiglu(pre(x, 2), ffn2_w_in, ffn2_w_out), 2, 0.5)
    return x


def setup_inputs(seed: int = 0) -> dict:
    key = jax.random.key(seed)
    L, D = DEPTH, D_MODEL
    ks = jax.random.split(key, 28)

    def nrm(j, shape, scale):
        return scale * jax.random.normal(ks[j], shape, jnp.float32)

    a_c = jax.random.uniform(ks[22], (L, 2, LRU_WIDTH), jnp.float32, 0.9, 0.999)
    sig = a_c ** (1.0 / LRU_C)
    lru_lambda = jnp.log(sig) - jnp.log1p(-sig)
    return {
        'x_prompt': nrm(0, (BATCH, SEQ, D), 1.0),
        'x_sample': nrm(1, (DEC_BATCH, DEC_SEQ, D), 1.0),
        'c_prompt': nrm(2, (BATCH, D), 1.0),
        'c_sample': nrm(3, (DEC_BATCH, D), 1.0),
        'w_ada': nrm(4, (L, D, N_SUB * 3 * D), 0.5 * D ** -0.5),
        'b_ada': nrm(5, (L, N_SUB * 3 * D), 0.01),
        'g_pre': 1.0 + nrm(6, (L, N_SUB, D), 0.02),
        'g_post': 1.0 + nrm(7, (L, N_SUB, D), 0.02),
        'ffn1_w_in': nrm(8, (L, D, 2 * D_FF), D ** -0.5),
        'ffn1_w_out': nrm(9, (L, D_FF, D), D_FF ** -0.5),
        'ffn2_w_in': nrm(10, (L, D, 2 * D_FF), D ** -0.5),
        'ffn2_w_out': nrm(11, (L, D_FF, D), D_FF ** -0.5),
        'w_mix_in': nrm(12, (L, D, MIX_IN_WIDTH), D ** -0.5),
        'gla_w_alpha': nrm(13, (L, 2, GLA_RANK, GLA_HEADS * GLA_DK), GLA_RANK ** -0.5),
        'gla_b_alpha': nrm(14, (L, 2, GLA_HEADS * GLA_DK), 0.1),
        'gla_norm_g': 1.0 + nrm(15, (L, GLA_DV), 0.02),
        'lru_conv_w': nrm(16, (L, 2, LRU_TAPS, LRU_WIDTH), LRU_TAPS ** -0.5),
        'lru_conv_b': nrm(17, (L, 2, LRU_WIDTH), 0.01),
        'lru_w_a': nrm(18, (L, 2, LRU_BLOCKS, LRU_BLOCK_DIM, LRU_BLOCK_DIM), LRU_BLOCK_DIM ** -0.5),
        'lru_b_a': nrm(19, (L, 2, LRU_WIDTH), 0.01),
        'lru_w_x': nrm(20, (L, 2, LRU_BLOCKS, LRU_BLOCK_DIM, LRU_BLOCK_DIM), LRU_BLOCK_DIM ** -0.5),
        'lru_b_x': nrm(21, (L, 2, LRU_WIDTH), 0.01),
        'lru_lambda': lru_lambda,
        'conf_dw_w': nrm(23, (L, CONF_TAPS, CONF_WIDTH), CONF_TAPS ** -0.5),
        'conf_dw_b': nrm(24, (L, CONF_WIDTH), 0.01),
        'conf_ln_g': 1.0 + nrm(25, (L, CONF_WIDTH), 0.02),
        'conf_ln_b': nrm(26, (L, CONF_WIDTH), 0.01),
        'w_mix_out': nrm(27, (L, MIX_WIDTH, D), MIX_WIDTH ** -0.5),
    }


def reference(x_prompt, x_sample, c_prompt, c_sample, w_ada, b_ada, g_pre, g_post,
              ffn1_w_in, ffn1_w_out, ffn2_w_in, ffn2_w_out, w_mix_in,
              gla_w_alpha, gla_b_alpha, gla_norm_g,
              lru_conv_w, lru_conv_b, lru_w_a, lru_b_a, lru_w_x, lru_b_x, lru_lambda,
              conf_dw_w, conf_dw_b, conf_ln_g, conf_ln_b, w_mix_out):
    def run(x, c):
        for l in range(DEPTH):
            x = encoder_layer(x, c, w_ada[l], b_ada[l], g_pre[l], g_post[l],
                              ffn1_w_in[l], ffn1_w_out[l], ffn2_w_in[l], ffn2_w_out[l],
                              w_mix_in[l], gla_w_alpha[l], gla_b_alpha[l], gla_norm_g[l],
                              lru_conv_w[l], lru_conv_b[l], lru_w_a[l], lru_b_a[l],
                              lru_w_x[l], lru_b_x[l], lru_lambda[l],
                              conf_dw_w[l], conf_dw_b[l], conf_ln_g[l], conf_ln_b[l], w_mix_out[l])
        return x

    y_prompt = run(x_prompt, c_prompt)
    y_sample = run(x_sample, c_sample)
    return (y_prompt, y_sample)
```

```cpp
#include <hip/hip_runtime.h>
#include <cstdio>
#include <cstdint>
#define MK_ONE_LAUNCH 1
namespace pg8 {
#define PG8_LAS __attribute__((address_space(3)))
typedef unsigned short bf16_t;
typedef short bf16x8 __attribute__((ext_vector_type(8)));
typedef float f32x4 __attribute__((ext_vector_type(4)));
typedef unsigned u32x4 __attribute__((ext_vector_type(4)));
constexpr int BM = 256, BK = 64, HALF = 128, HTB = HALF * BK * 2  , STAGE_BYTES = 8 * HTB, NXCD = 8;

__host__ __device__ __forceinline__ int lds_byte(int r, int c) { const int st = (r >> 4) * 2 + (c >> 5), rr = r & 15, cc = c & 31, ob = rr * 64 + cc * 2; return st * 1024 + (ob ^ (((ob >> 9) & 1) << 5)); }
__host__ __device__ __forceinline__ void stage_rc(int b, int& R, int& C) { const int st = b / 1024, sb = b % 1024, swz = sb ^ (((sb >> 9) & 1) << 5); R = (st >> 1) * 16 + swz / 64; C = (st & 1) * 32 + (swz % 64) / 2; }
__host__ __device__ __forceinline__ int perm32(int rho) { const int n = rho >> 4, i = rho & 15; return 8 * (i >> 2) + 4 * n + (i & 3); }

struct Unit { int pm, pn; };
struct Gemm { const bf16_t* A; const bf16_t* Bt; int M, N, K; };

struct StaticOrder {
    int nM, nN, nwg, G, c, WGM;
    __host__ __device__ void init(int M, int N, int G_, int c_, int wgm = 8) { nM = M / BM; nN = N / BM; nwg = nM * nN; G = G_; c = c_; WGM = wgm; }
    __host__ __device__ bool next(int i, Unit& u) const {
        const long L = (long)i * G + c; if (L >= nwg) return false;
        int wgid = (int)L; { const int q = nwg / NXCD, r = nwg % NXCD, xcd = wgid % NXCD, off = wgid / NXCD; wgid = (xcd < r ? xcd * (q + 1) : r * (q + 1) + (xcd - r) * q) + off; }
        const int nig = WGM * nN, gid = wgid / nig, fm = gid * WGM, gsz = (nM - fm) < WGM ? (nM - fm) : WGM;
        u.pm = fm + ((wgid % nig) % gsz); u.pn = (wgid % nig) / gsz; return true;
    }
    __device__ __forceinline__ void a_ready(const Unit&) const {}
    __device__ __forceinline__ void done(const Unit&) const {}
};

struct SameTileOrder : StaticOrder {
    __host__ __device__ bool next(int i, Unit& u) const { const bool ok = StaticOrder::next(i, u); u.pm = 0; u.pn = 0; return ok; }
};
typedef __bf16 bf16v2_t __attribute__((ext_vector_type(2))); typedef float f32x2_t __attribute__((ext_vector_type(2)));
__device__ __forceinline__ unsigned cvt_pk_bf16(float lo, float hi) { const f32x2_t v = {lo, hi}; const bf16v2_t b = __builtin_convertvector(v, bf16v2_t); return __builtin_bit_cast(unsigned, b); }

#define EPI_STORE(p, v) (*(p) = (v))
struct EpiBf16 {
    static constexpr bool PERM = true, AFTER_DRAIN = false;
    bf16_t* O; int ldc; int mode;
    __device__ __forceinline__ void operator()(const f32x4 (&acc)[2][2][4][2], const Unit& u, int wr, int wc, int fr, int fq) const {
        const int row0 = u.pm * BM + wr * 64 + fr; const int col0 = u.pn * BM + wc * 32 + 8 * fq;
        const int act = mode == 0 ? 0 : ((u.pn == 4 || u.pn == 5) ? 1 : ((u.pn == 8 || u.pn == 9) ? 2 : ((u.pn >= 10 && u.pn < 14) ? 3 : 0)));
        if (act == 3) {
            const int colg = 10 * BM + (u.pn - 10) * HALF + wc * 32 + 8 * fq;
#pragma unroll
            for (int ai = 0; ai < 2; ++ai)
#pragma unroll
                for (int m = 0; m < 4; ++m) { bf16_t* rowp = O + (size_t)(row0 + ai * HALF + m * 16) * ldc + colg; float h[8];
#pragma unroll
                    for (int n = 0; n < 2; ++n)
#pragma unroll
                        for (int j = 0; j < 4; ++j) { const float v = acc[ai][0][m][n][j], g = acc[ai][1][m][n][j]; h[n * 4 + j] = v * __builtin_amdgcn_rcpf(1.0f + __expf(-g)); }
                    u32x4 w; w.x = cvt_pk_bf16(h[0], h[1]); w.y = cvt_pk_bf16(h[2], h[3]); w.z = cvt_pk_bf16(h[4], h[5]); w.w = cvt_pk_bf16(h[6], h[7]);
                    EPI_STORE((u32x4*)rowp, w); }
            return; }
#pragma unroll
        for (int ai = 0; ai < 2; ++ai)
#pragma unroll
            for (int m = 0; m < 4; ++m) { bf16_t* rowp = O + (size_t)(row0 + ai * HALF + m * 16) * ldc + col0;
#pragma unroll
                for (int bj = 0; bj < 2; ++bj) { f32x4 v0 = acc[ai][bj][m][0], v1 = acc[ai][bj][m][1];
                    if (act == 1) {
#pragma unroll
                        for (int j = 0; j < 4; ++j) { v0[j] = v0[j] * __builtin_amdgcn_rcpf(1.0f + __expf(-v0[j])); v1[j] = v1[j] * __builtin_amdgcn_rcpf(1.0f + __expf(-v1[j])); } }
                    if (act == 2) {
#pragma unroll
                        for (int j = 0; j < 4; ++j) { v0[j] = v0[j] * __builtin_amdgcn_rcpf(1.0f + __expf(-1.5957691216f * (v0[j] + 0.044715f * v0[j] * v0[j] * v0[j])));
                            v1[j] = v1[j] * __builtin_amdgcn_rcpf(1.0f + __expf(-1.5957691216f * (v1[j] + 0.044715f * v1[j] * v1[j] * v1[j]))); } }
                    u32x4 w; w.x = cvt_pk_bf16(v0[0], v0[1]); w.y = cvt_pk_bf16(v0[2], v0[3]); w.z = cvt_pk_bf16(v1[0], v1[1]); w.w = cvt_pk_bf16(v1[2], v1[3]);
                    EPI_STORE((u32x4*)(rowp + bj * HALF), w); } }
    }
};
struct EpiSwiGLU {
    static constexpr bool PERM = true, AFTER_DRAIN = false;
    bf16_t* O; int ldc;
    __device__ __forceinline__ void operator()(const f32x4 (&acc)[2][2][4][2], const Unit& u, int wr, int wc, int fr, int fq) const {
        const int row0 = u.pm * BM + wr * 64 + fr; const int col0 = u.pn * HALF + wc * 32 + 8 * fq;
#pragma unroll
        for (int ai = 0; ai < 2; ++ai)
#pragma unroll
            for (int m = 0; m < 4; ++m) { bf16_t* rowp = O + (size_t)(row0 + ai * HALF + m * 16) * ldc + col0;
                float h[8];
#pragma unroll
                for (int n = 0; n < 2; ++n)
#pragma unroll
                    for (int j = 0; j < 4; ++j) { const float up = acc[ai][0][m][n][j], g = acc[ai][1][m][n][j];
                        h[n * 4 + j] = up * g * __builtin_amdgcn_rcpf(1.0f + __builtin_amdgcn_exp2f(g)); }
                u32x4 w; w.x = cvt_pk_bf16(h[0], h[1]); w.y = cvt_pk_bf16(h[2], h[3]); w.z = cvt_pk_bf16(h[4], h[5]); w.w = cvt_pk_bf16(h[6], h[7]);
                EPI_STORE((u32x4*)rowp, w); }
    }
};

template <class Epi, class Sched, bool ALIGN_EPI = false, bool SP2 = false>
__device__ __forceinline__ void gemm_phase(PG8_LAS unsigned char* lds, const Gemm g, const Sched& S, const Epi& E, const int tid) {
    const int wid = __builtin_amdgcn_readfirstlane(tid >> 6), lane = tid & 63, wr = wid >> 2, wc = wid & 3, fr = lane & 15, fq = lane >> 4;
    const int K = g.K, nt = K / BK;
    unsigned voffA[2], voffB[2];
#pragma unroll
    for (int i = 0; i < 2; ++i) { int R, C; stage_rc(tid * 16 + i * 8192, R, C); const int Rb = Epi::PERM ? ((R & ~31) + perm32(R & 31)) : R;
        voffA[i] = (unsigned)(R * K + C) * 2u; voffB[i] = (unsigned)(Rb * K + C) * 2u; }
    const size_t kstep = (size_t)(BK * 2);
    const size_t hstep = (size_t)HALF * K * 2;
    const size_t tstep = 2 * hstep;
    const unsigned ldsw = (unsigned)wid * 1024u;
    const int aoff = lds_byte(wr * 64 + fr, fq * 8), boff = lds_byte(wc * 32 + fr, fq * 8);
#define PG8_SA(b, h) (((b) * 2 + (h)) * HTB)
#define PG8_SB(b, h) ((4 + (b) * 2 + (h)) * HTB)
#define PG8_STAGE(bufoff, gbase, voff) do { _Pragma("unroll") for (int _i = 0; _i < 2; ++_i) \
        __builtin_amdgcn_global_load_lds((const unsigned*)((const char*)(gbase) + (voff)[_i]), (PG8_LAS unsigned*)(lds + (bufoff) + ldsw + _i * 8192), 16, 0, 0); } while (0)
#define PG8_LDA(dst, b, h) do { _Pragma("unroll") for (int m = 0; m < 4; ++m) _Pragma("unroll") for (int k = 0; k < 2; ++k) dst[m][k] = *(const PG8_LAS bf16x8*)(lds + PG8_SA(b, h) + aoff + m * 2048 + k * 1024); } while (0)
#define PG8_LDB(dst, b, h) do { _Pragma("unroll") for (int n = 0; n < 2; ++n) _Pragma("unroll") for (int k = 0; k < 2; ++k) dst[n][k] = *(const PG8_LAS bf16x8*)(lds + PG8_SB(b, h) + boff + n * 2048 + k * 1024); } while (0)
#define PG8_MMA(ai, bj, At, Bt) do { __builtin_amdgcn_s_setprio(1); _Pragma("unroll") for (int m = 0; m < 4; ++m) _Pragma("unroll") for (int n = 0; n < 2; ++n) _Pragma("unroll") for (int k = 0; k < 2; ++k) \
        acc[ai][bj][m][n] = __builtin_amdgcn_mfma_f32_16x16x32_bf16(Bt[n][k], At[m][k], acc[ai][bj][m][n], 0, 0, 0); __builtin_amdgcn_s_setprio(0); } while (0)
#define PG8_WAIT_V(n) asm volatile("s_waitcnt vmcnt(" #n ")" ::: "memory")
#define PG8_WAIT_L(n) asm volatile("s_waitcnt lgkmcnt(" #n ")" ::: "memory")
#define PG8_BAR __builtin_amdgcn_s_barrier()
#define PG8_SCHED __builtin_amdgcn_sched_barrier(0)
    Unit cur, nxt; int ui = 0;
    if (!S.next(0, cur)) return;
    f32x4 acc[2][2][4][2];
#pragma unroll
    for (int a = 0; a < 2; ++a)
#pragma unroll
        for (int b = 0; b < 2; ++b)
#pragma unroll
            for (int m = 0; m < 4; ++m)
#pragma unroll
                for (int n = 0; n < 2; ++n) acc[a][b][m][n] = (f32x4){0.f, 0.f, 0.f, 0.f};
    bf16x8 At[4][2], B0[2][2], B1[2][2];
    const char* cA = (const char*)g.A + (size_t)cur.pm * tstep; const char* cB = (const char*)g.Bt + (size_t)cur.pn * tstep;
    S.a_ready(cur);
    if constexpr (SP2) {
        PG8_STAGE(PG8_SB(0, 0), cB, voffB); PG8_STAGE(PG8_SB(0, 1), cB + hstep, voffB); PG8_STAGE(PG8_SA(0, 0), cA, voffA); PG8_STAGE(PG8_SA(0, 1), cA + hstep, voffA);
        if (wr == 1) PG8_BAR;
        PG8_WAIT_V(2); PG8_BAR;
        PG8_STAGE(PG8_SB(1, 0), cB + kstep, voffB); PG8_STAGE(PG8_SA(1, 0), cA + kstep, voffA); PG8_STAGE(PG8_SB(1, 1), cB + hstep + kstep, voffB);
        PG8_WAIT_V(6); PG8_BAR;
    } else {
        PG8_STAGE(PG8_SB(0, 0), cB, voffB); PG8_STAGE(PG8_SA(0, 0), cA, voffA); PG8_STAGE(PG8_SB(0, 1), cB + hstep, voffB); PG8_STAGE(PG8_SA(0, 1), cA + hstep, voffA);
        if (wr == 1) PG8_BAR;
        PG8_WAIT_V(4); PG8_BAR;
        PG8_STAGE(PG8_SB(1, 0), cB + kstep, voffB); PG8_STAGE(PG8_SA(1, 0), cA + kstep, voffA); PG8_STAGE(PG8_SB(1, 1), cB + hstep + kstep, voffB);
        PG8_WAIT_V(6); PG8_BAR;
    }
    for (;;) {
        const bool has_next = S.next(ui + 1, nxt);
        const char* nA = has_next ? (const char*)g.A + (size_t)nxt.pm * tstep : cA; const char* nB = has_next ? (const char*)g.Bt + (size_t)nxt.pn * tstep : cB;
        for (int t = 0; t < nt; t += 2) {
            const bool last = (t == nt - 2);
            const char* a1 = cA + (size_t)(t + 1) * kstep;
            const char* a2 = last ? nA : cA + (size_t)(t + 2) * kstep; const char* b2 = last ? nB : cB + (size_t)(t + 2) * kstep;
            const char* a3 = a2 + kstep; const char* b3 = b2 + kstep;
            if (last && has_next) S.a_ready(nxt);
            if constexpr (SP2) {
            PG8_LDB(B0, 0, 0); PG8_LDB(B1, 0, 1); PG8_SCHED; PG8_LDA(At, 0, 0); PG8_STAGE(PG8_SA(1, 1), a1 + hstep, voffA);
            PG8_WAIT_V(8); PG8_WAIT_L(0); PG8_BAR; PG8_MMA(0, 0, At, B0); PG8_MMA(0, 1, At, B1); PG8_BAR; PG8_SCHED;
            PG8_LDA(At, 0, 1); PG8_STAGE(PG8_SB(0, 0), b2, voffB); PG8_STAGE(PG8_SB(0, 1), b2 + hstep, voffB); PG8_STAGE(PG8_SA(0, 0), a2, voffA);
            PG8_WAIT_V(8); PG8_WAIT_L(0); PG8_BAR; PG8_MMA(1, 0, At, B0); PG8_MMA(1, 1, At, B1); PG8_BAR; PG8_SCHED;
            PG8_LDB(B0, 1, 0); PG8_LDB(B1, 1, 1); PG8_SCHED; PG8_LDA(At, 1, 0); PG8_STAGE(PG8_SA(0, 1), a2 + hstep, voffA);
            PG8_WAIT_V(8); PG8_WAIT_L(0); PG8_BAR; PG8_MMA(0, 0, At, B0); PG8_MMA(0, 1, At, B1); PG8_BAR; PG8_SCHED;
            PG8_LDA(At, 1, 1); PG8_STAGE(PG8_SB(1, 0), b3, voffB); PG8_STAGE(PG8_SB(1, 1), b3 + hstep, voffB); PG8_STAGE(PG8_SA(1, 0), a3, voffA);
            PG8_WAIT_V(8); PG8_WAIT_L(0); PG8_BAR; PG8_MMA(1, 0, At, B0); PG8_MMA(1, 1, At, B1); PG8_BAR; PG8_SCHED;
            } else {
            PG8_LDB(B0, 0, 0); PG8_SCHED; PG8_LDA(At, 0, 0); PG8_STAGE(PG8_SA(1, 1), a1 + hstep, voffA);
            PG8_WAIT_L(8); PG8_BAR; PG8_WAIT_L(0); PG8_MMA(0, 0, At, B0); PG8_BAR; PG8_SCHED;
            PG8_LDB(B1, 0, 1); PG8_STAGE(PG8_SB(0, 0), b2, voffB);
            PG8_BAR; PG8_WAIT_L(0); PG8_MMA(0, 1, At, B1); PG8_BAR;
            PG8_LDA(At, 0, 1); PG8_STAGE(PG8_SA(0, 0), a2, voffA);
            PG8_BAR; PG8_WAIT_L(0); PG8_MMA(1, 0, At, B0); PG8_BAR; PG8_SCHED;
            PG8_STAGE(PG8_SB(0, 1), b2 + hstep, voffB);
            PG8_WAIT_V(6); PG8_BAR; PG8_MMA(1, 1, At, B1); PG8_BAR;
            PG8_LDB(B0, 1, 0); PG8_SCHED; PG8_LDA(At, 1, 0); PG8_STAGE(PG8_SA(0, 1), a2 + hstep, voffA);
            PG8_WAIT_L(8); PG8_BAR; PG8_WAIT_L(0); PG8_MMA(0, 0, At, B0); PG8_BAR; PG8_SCHED;
            PG8_LDB(B1, 1, 1); PG8_STAGE(PG8_SB(1, 0), b3, voffB);
            PG8_BAR; PG8_WAIT_L(0); PG8_MMA(0, 1, At, B1); PG8_BAR;
            PG8_LDA(At, 1, 1); PG8_STAGE(PG8_SA(1, 0), a3, voffA);
            PG8_BAR; PG8_WAIT_L(0); PG8_MMA(1, 0, At, B0); PG8_BAR; PG8_SCHED;
            PG8_STAGE(PG8_SB(1, 1), b3 + hstep, voffB);
            PG8_WAIT_V(6); PG8_BAR; PG8_MMA(1, 1, At, B1); PG8_BAR;
            }
        }
        if constexpr (ALIGN_EPI) { if (wr == 0) PG8_BAR; }
        if constexpr (!Epi::AFTER_DRAIN) { E(acc, cur, wr, wc, fr, fq); S.done(cur); }
        if (!has_next) break;
#pragma unroll
        for (int a = 0; a < 2; ++a)
#pragma unroll
            for (int b = 0; b < 2; ++b)
#pragma unroll
                for (int m = 0; m < 4; ++m)
#pragma unroll
                    for (int n = 0; n < 2; ++n) acc[a][b][m][n] = (f32x4){0.f, 0.f, 0.f, 0.f};
        cur = nxt; cA = nA; cB = nB; ++ui;
        if constexpr (ALIGN_EPI) { if (wr == 1) PG8_BAR; }
    }
    PG8_WAIT_V(0);
    if constexpr (!ALIGN_EPI) { if (wr == 0) PG8_BAR; }
    PG8_BAR;
#undef PG8_SA
#undef PG8_SB
#undef PG8_STAGE
#undef PG8_LDA
#undef PG8_LDB
#undef PG8_MMA
#undef PG8_WAIT_V
#undef PG8_WAIT_L
#undef PG8_BAR
#undef PG8_SCHED
}
}
constexpr int D = 2048, SEQ = 8192, NSEQ = 5, M = NSEQ * SEQ, DFF = 5632, NUP = 2 * DFF, MIW = 4128, NLAYER = 2, NADA = 9 * D;
constexpr int NPC = 4352;
constexpr int NZ = 288;
constexpr int P_Q = 0, P_K = 256, P_V = 512, P_OG = 1024, P_RI = 1536, P_RG = 2048, P_CV = 2560, P_ZR = 3584, P_ZI = P_ZR + NZ, P_AL = P_ZI + NZ, P_PAD = P_AL + 32;
static_assert(P_PAD == 4192 && P_PAD <= NPC, "P columns");
constexpr float EPS = 1e-6f;
constexpr int NWAVES = 8, NTHR = 512;
constexpr int MOD_KS = 16;

constexpr size_t MiB = 1u << 20;
constexpr size_t WS_CTL = 0, CTL_ZERO_BYTES = 64 * 1024;
constexpr size_t WS_VEC = 1 * MiB;
constexpr size_t VEC_ELEMS = (size_t)NLAYER * 3 * NSEQ * D;
constexpr size_t WS_SMALL = 2 * MiB;
constexpr size_t SM_W1 = 0, SM_W2 = 64 * 1024, SM_WAT = 256 * 1024, SM_WXT = 512 * 1024, SM_SPT = 768 * 1024;
constexpr size_t WS_WUP = 3 * MiB;
constexpr size_t WS_WDN = 179 * MiB;
constexpr size_t WS_WMI = 267 * MiB;
constexpr size_t WS_WMO = 305 * MiB;
constexpr size_t WS_H = 321 * MiB;
constexpr size_t WS_U = 481 * MiB;
constexpr size_t WS_MODP = WS_U;
constexpr size_t WS_QD = 861 * MiB;
constexpr size_t WS_DD = 901 * MiB;
constexpr size_t WS_LSUM = 903 * MiB;
constexpr size_t WS_G = 921 * MiB;
constexpr size_t WS_FT = WS_G;
constexpr size_t WS_OI = WS_G + 80 * MiB;
constexpr size_t WS_LS = 1081 * MiB;
constexpr size_t WS_END = 1161 * MiB;
static_assert(WS_WUP + 4 * (size_t)NUP * D * 2 <= WS_WDN && WS_WDN + 4 * (size_t)D * DFF * 2 <= WS_WMI && WS_WMI + 2 * (size_t)NPC * D * 2 <= WS_WMO && WS_WMO + 2 * (size_t)D * D * 2 <= WS_H, "ws map 1");
static_assert(WS_H + (size_t)M * D * 2 <= WS_U && WS_U + (size_t)M * DFF * 2 <= WS_G && WS_U + (size_t)M * NPC * 2 <= WS_QD && WS_QD + 2 * (size_t)M * 256 * 2 <= WS_DD, "ws map 2");
static_assert(WS_DD + 5120 * 64 * 4 <= WS_LSUM && WS_LSUM + (size_t)NSEQ * 2 * 128 * 3 * 512 * 4 <= WS_G && WS_G + (size_t)M * D * 2 <= WS_LS && WS_LS + (size_t)5120 * 8192 * 2 <= WS_END, "ws map 3");
static_assert(WS_MODP + (size_t)NLAYER * MOD_KS * NSEQ * NADA * 4 <= WS_QD && WS_VEC + 3 * VEC_ELEMS * 4 <= WS_SMALL, "ws map 4");
constexpr int X16_SPLIT = 22528;
static_assert((size_t)X16_SPLIT * D * 2 <= 2 * (size_t)NUP * D * 2 && (size_t)(M - X16_SPLIT) * D * 2 <= 80 * MiB, "x16 parking");
constexpr int CW_BAR = 1024;

constexpr int RING_BYTES = 131072;
constexpr int MISC_OFF = 155648;
constexpr int LDS_BYTES = 159744;

#define DI __device__ __forceinline__
#define LAS __attribute__((address_space(3)))
typedef unsigned short bf16;
typedef unsigned v4u __attribute__((ext_vector_type(4)));
typedef unsigned v2u __attribute__((ext_vector_type(2)));
typedef float f32x4 __attribute__((ext_vector_type(4)));
typedef float f32x2 __attribute__((ext_vector_type(2)));
typedef short bf16x8 __attribute__((ext_vector_type(8)));
#define LDS_WAIT() asm volatile("s_waitcnt lgkmcnt(0)" ::: "memory")
#define LDS_BARRIER() do { asm volatile("s_waitcnt lgkmcnt(0)" ::: "memory"); __builtin_amdgcn_s_barrier(); asm volatile("" ::: "memory"); } while (0)
DI float bflo(unsigned w) { return __uint_as_float(w << 16); }
DI float bfhi(unsigned w) { return __uint_as_float(w & 0xffff0000u); }
DI float bf1(bf16 b) { return __uint_as_float((unsigned)b << 16); }
typedef __bf16 bf16v2 __attribute__((ext_vector_type(2)));
DI unsigned pk2(float lo, float hi) { const f32x2 v = {lo, hi}; const bf16v2 b = __builtin_convertvector(v, bf16v2); return __builtin_bit_cast(unsigned, b); }
DI bf16 f2bf(float f) { return (bf16)(pk2(f, 0.f) & 0xffffu); }
DI float sigm(float x) { return __builtin_amdgcn_rcpf(1.0f + __expf(-x)); }
DI float silu_f(float x) { return x * sigm(x); }
DI float gelu_tanh_f(float x) { return x * sigm(1.5957691216f * (x + 0.044715f * x * x * x)); }
DI float logsigmoid_f(float z) { return fminf(z, 0.f) - __logf(1.0f + __expf(-fabsf(z))); }
DI float wave_sum(float v) {
#pragma unroll
    for (int o = 1; o < 64; o <<= 1) v += __shfl_xor(v, o);
    return v;
}
DI f32x4 mfma16(bf16x8 a, bf16x8 b, f32x4 c) { return __builtin_amdgcn_mfma_f32_16x16x32_bf16(a, b, c, 0, 0, 0); }
DI bf16x8 mk8(v4u w) { return __builtin_bit_cast(bf16x8, w); }
DI bf16x8 mk8(v2u lo, v2u hi) { v4u w; w.x = lo.x; w.y = lo.y; w.z = hi.x; w.w = hi.y; return __builtin_bit_cast(bf16x8, w); }
DI void split8(const unsigned (&w)[8], bf16x8& ev, bf16x8& od) {
    v4u e, o;
    e.x = (w[0] & 0xffffu) | (w[1] << 16); e.y = (w[2] & 0xffffu) | (w[3] << 16); e.z = (w[4] & 0xffffu) | (w[5] << 16); e.w = (w[6] & 0xffffu) | (w[7] << 16);
    o.x = (w[0] >> 16) | (w[1] & 0xffff0000u); o.y = (w[2] >> 16) | (w[3] & 0xffff0000u); o.z = (w[4] >> 16) | (w[5] & 0xffff0000u); o.w = (w[6] >> 16) | (w[7] & 0xffff0000u);
    ev = __builtin_bit_cast(bf16x8, e); od = __builtin_bit_cast(bf16x8, o);
}

#define XB_TMO      128
#define XB_XCNT(j)  (256  + 64 * (j))
#define XB_XSUB(j)  (1280 + 64 * (j))
#define XB_XGEN(j)  (2304 + 64 * (j))
#define XB_TOP      3328
#define XB_TOPGEN   3392
#define XCD_BAR_WORDS 3456
#define XB_SPIN_CAP (1u << 22)
static_assert((CW_BAR + XCD_BAR_WORDS) * 4 <= (int)CTL_ZERO_BYTES, "barrier words inside the memset region");
__device__ __forceinline__ unsigned xb_ld(unsigned* p)              { return __hip_atomic_load(p, __ATOMIC_RELAXED, __HIP_MEMORY_SCOPE_AGENT); }
__device__ __forceinline__ unsigned xb_add(unsigned* p, unsigned v) { return __hip_atomic_fetch_add(p, v, __ATOMIC_RELAXED, __HIP_MEMORY_SCOPE_AGENT); }
__device__ __forceinline__ unsigned xb_xcc_id() { return (unsigned)__builtin_amdgcn_s_getreg((3 << 11) | 20) & 0xFu; }
#define XB_SPIN(cond, bar) do { unsigned _sp = 0; while (cond) { __builtin_amdgcn_s_sleep(1); \
    if ((++_sp & 255u) == 0u) { if (xb_ld(&(bar)[XB_TMO])) break; if (_sp > XB_SPIN_CAP) { atomicAdd(&(bar)[XB_TMO], 1u); break; } } } } while (0)
struct XcdBarrier { unsigned* bar; unsigned x; volatile LAS unsigned* st; };
__device__ __forceinline__ XcdBarrier xcd_barrier_post(unsigned* bar, volatile LAS unsigned* st) {
    XcdBarrier b; b.bar = bar; b.x = xb_xcc_id(); b.st = st;
    if (threadIdx.x == 0) (void)xb_add(&bar[XB_XCNT(b.x)], 1u);
    return b;
}
__device__ __forceinline__ void xcd_barrier_complete(unsigned* bar, unsigned x, unsigned& nloc, unsigned& nx) {
    const unsigned G = gridDim.x * gridDim.y * gridDim.z;
    unsigned sum, cnt, mine, sp = 0u;
    for (;;) {
        sum = 0u; cnt = 0u; mine = 0u;
#pragma unroll
        for (unsigned j = 0; j < 16; ++j) { const unsigned c = xb_ld(&bar[XB_XCNT(j)]); sum += c; cnt += (c > 0u) ? 1u : 0u; mine = (j == x) ? c : mine; }
        if (sum == G) break;
        __builtin_amdgcn_s_sleep(1);
        if ((++sp & 255u) == 0u) { if (xb_ld(&bar[XB_TMO])) break; if (sp > XB_SPIN_CAP) { atomicAdd(&bar[XB_TMO], 1u); break; } }
    }
    nloc = mine > 0u ? mine : 1u; nx = cnt > 0u ? cnt : 1u;
}
__device__ __forceinline__ void xcd_barrier(const XcdBarrier& b) {
    asm volatile("s_waitcnt vmcnt(0)" ::: "memory");
    __syncthreads();
    if (threadIdx.x == 0) {
        unsigned* bar = b.bar;
        __builtin_amdgcn_s_waitcnt(0);
        unsigned nloc = b.st[0], nx = b.st[1];
        if (nloc == 0u) { xcd_barrier_complete(bar, b.x, nloc, nx); b.st[0] = nloc; b.st[1] = nx; }
        const unsigned old = xb_add(&bar[XB_XSUB(b.x)], 1u);
        const unsigned gen = old / nloc;
        if (old + 1u == (gen + 1u) * nloc) {
            __builtin_amdgcn_fence(__ATOMIC_RELEASE, "agent");
            asm volatile("s_waitcnt vmcnt(0)" ::: "memory");
            const unsigned og = xb_add(&bar[XB_TOP], 1u);
            const unsigned tg = og / nx;
            if (og + 1u == (tg + 1u) * nx) xb_add(&bar[XB_TOPGEN], 1u);
            else XB_SPIN(xb_ld(&bar[XB_TOPGEN]) == tg, bar);
            __builtin_amdgcn_fence(__ATOMIC_ACQUIRE, "agent");
            xb_add(&bar[XB_XGEN(b.x)], 1u);
            asm volatile("s_waitcnt vmcnt(0)" ::: "memory");
        } else {
            XB_SPIN(xb_ld(&bar[XB_XGEN(b.x)]) == gen, bar);
            __builtin_amdgcn_fence(__ATOMIC_ACQUIRE, "agent");
            asm volatile("s_waitcnt vmcnt(0)" ::: "memory");
        }
    }
    __syncthreads();
}

struct Frame {
    LAS unsigned char* lds;
    int tid, lane, wave, bid, G, gw, NGW;
    float* out; unsigned char* ws;
};
DI void transpose_item(const float* W, int Nsrc, int K, bf16* WT, int n0, int k0, int dst_row0, LAS float* scr, int lane, float scale = 1.0f) {
#pragma unroll 8
    for (int i = 0; i < 32; ++i) { const int kk = 2 * i + (lane >> 5); scr[kk * 33 + (lane & 31)] = scale * W[(size_t)(k0 + kk) * Nsrc + n0 + (lane & 31)]; }
    LDS_WAIT(); asm volatile("" ::: "memory");
    const int c = lane & 7;
#pragma unroll
    for (int j = 0; j < 4; ++j) { const int n = (lane >> 3) + 8 * j; const LAS float* s = scr + (8 * c) * 33 + n;
        v4u o; o.x = pk2(s[0 * 33], s[1 * 33]); o.y = pk2(s[2 * 33], s[3 * 33]); o.z = pk2(s[4 * 33], s[5 * 33]); o.w = pk2(s[6 * 33], s[7 * 33]);
        *(v4u*)(WT + (size_t)(dst_row0 + n) * K + k0 + 8 * c) = o; }
    LDS_WAIT(); asm volatile("" ::: "memory");
}
DI int mixin_dst_row(int n) {
    if (n < 768) return P_Q + (n - 512);
    if (n < 1024) return P_K + (n - 768);
    if (n < 1536) return P_V + (n - 1024);
    if (n < 2048) return P_OG + (n - 1536);
    if (n < 2080) return P_AL + (n - 2048);
    if (n < 2592) return P_RI + (n - 2080);
    if (n < 3104) return P_RG + (n - 2592);
    if (n < 3616) { const int j = n - 3104; return P_CV + 256 * (j / 128) + (j % 128); }
    { const int j = n - 3616; return P_CV + 256 * (j / 128) + 128 + (j % 128); }
}
struct ProArgs { const float *c_prompt, *c_sample, *w_ada, *w1in, *w1out, *w2in, *w2out, *wmi, *wmo, *lru_wa, *lru_wx, *lru_lam; };
DI void prologue_a(const Frame& F, const ProArgs& A) {
    unsigned char* ws = F.ws;
    LAS float* scr = (LAS float*)(F.lds + F.wave * 8704);
    LAS float* sc = (LAS float*)(F.lds + 69632);
    LAS float* ctab = (LAS float*)(F.lds + 69632 + 40960);
    for (int i = F.tid; i < NSEQ * D; i += NTHR) { const float c = i < D ? A.c_prompt[i] : A.c_sample[i - D]; sc[i] = silu_f(c); }
    if (F.tid < 128) ctab[F.tid] = __builtin_amdgcn_cosf((float)F.tid * (1.0f / 128.0f)) * 0.08838834764831845f;
    __syncthreads();
    constexpr int I_UP = (D / 64) * (NUP / 32), I_DN = (DFF / 64) * (D / 32), I_MI = (D / 64) * ((MIW - 512) / 32), I_MO = (D / 64) * (D / 32), I_FOLD = 32 * (2 * NZ / 32), I_PAD = NPC - P_PAD, I_MOD = MOD_KS * (NADA / 256);
    constexpr int I_LAYER = 2 * I_UP + 2 * I_DN + I_MI + I_MO + I_FOLD + I_PAD + I_MOD;
    for (int it = F.gw; it < NLAYER * I_LAYER; it += F.NGW) {
        const int l = it / I_LAYER; int r = it - l * I_LAYER;
        if (r < I_MOD) {
            const int ks = r / (NADA / 256), cb = r % (NADA / 256), n = cb * 256 + F.lane * 4;
            const float* wp = A.w_ada + ((size_t)l * D + ks * 128) * NADA + n;
            f32x4 acc[NSEQ];
#pragma unroll
            for (int s = 0; s < NSEQ; ++s) acc[s] = (f32x4){0.f, 0.f, 0.f, 0.f};
#pragma unroll 8
            for (int k = 0; k < 128; ++k) { const f32x4 w = *(const f32x4*)(wp + (size_t)k * NADA);
#pragma unroll
                for (int s = 0; s < NSEQ; ++s) acc[s] += w * sc[s * D + ks * 128 + k]; }
            float* mp = (float*)(ws + WS_MODP) + ((size_t)(l * MOD_KS + ks) * NSEQ) * NADA + n;
#pragma unroll
            for (int s = 0; s < NSEQ; ++s) *(f32x4*)(mp + (size_t)s * NADA) = acc[s];
            continue; }
        r -= I_MOD;
        if (r < 2 * I_UP) {
            const int f = r / I_UP; r -= f * I_UP; const int kb = r / (NUP / 32), nb = r % (NUP / 32), n0 = nb * 32;
            const int j0 = n0 < DFF ? n0 : n0 - DFF, dst = 256 * (j0 / 128) + (n0 < DFF ? 0 : 128) + (j0 % 128);
            transpose_item((f ? A.w2in : A.w1in) + (size_t)l * D * NUP, NUP, D, (bf16*)(ws + WS_WUP) + (size_t)(l * 2 + f) * NUP * D, n0, kb * 64, dst, scr, F.lane, n0 < DFF ? -0.6931471805599453f : -1.4426950408889634f); continue; }
        r -= 2 * I_UP;
        if (r < 2 * I_DN) {
            const int f = r / I_DN; r -= f * I_DN; const int kb = r / (D / 32), nb = r % (D / 32);
            transpose_item((f ? A.w2out : A.w1out) + (size_t)l * DFF * D, D, DFF, (bf16*)(ws + WS_WDN) + (size_t)(l * 2 + f) * D * DFF, nb * 32, kb * 64, nb * 32, scr, F.lane); continue; }
        r -= 2 * I_DN;
        if (r < I_MI) {
            const int kb = r / ((MIW - 512) / 32), nb = r % ((MIW - 512) / 32), n0 = 512 + nb * 32;
            transpose_item(A.wmi + (size_t)l * D * MIW, MIW, D, (bf16*)(ws + WS_WMI) + (size_t)l * NPC * D, n0, kb * 64, mixin_dst_row(n0), scr, F.lane); continue; }
        r -= I_MI;
        if (r < I_MO) {
            const int kb = r / (D / 32), nb = r % (D / 32);
            transpose_item(A.wmo + (size_t)l * D * D, D, D, (bf16*)(ws + WS_WMO) + (size_t)l * D * D, nb * 32, kb * 64, nb * 32, scr, F.lane); continue; }
        r -= I_MO;
        if (r < I_FOLD) {
            constexpr int NRB = 2 * NZ / 32; const int kb = r / NRB, rb = r % NRB, reim = rb / (NZ / 32), q0 = (rb % (NZ / 32)) * 32;
            const float* wbase = A.wmi + (size_t)l * D * MIW + (size_t)(kb * 64 + F.lane) * MIW;
            float acc[32];
#pragma unroll
            for (int j = 0; j < 32; ++j) acc[j] = 0.f;
            if (q0 < 256) {
                const int g = q0 >> 6, cp0 = q0 & 63; const float* wrow = wbase + g * 128;
                for (int c4 = 0; c4 < 32; ++c4) { const f32x4 w = *(const f32x4*)(wrow + c4 * 4);
#pragma unroll
                    for (int e = 0; e < 4; ++e) { const int c = c4 * 4 + e;
#pragma unroll
                        for (int j = 0; j < 32; ++j) acc[j] += w[e] * ctab[(c * (cp0 + j) + reim * 32) & 127]; } }
            } else if (reim == 0) {
                for (int c4 = 0; c4 < 32; ++c4) {
#pragma unroll
                    for (int g = 0; g < 4; ++g) { const f32x4 w = *(const f32x4*)(wbase + g * 128 + c4 * 4); acc[g] += ((w[0] - w[1]) + (w[2] - w[3])) * 0.08838834764831845f; } }
            }
            bf16* dst = (bf16*)(ws + WS_WMI) + (size_t)l * NPC * D + (size_t)((reim ? P_ZI : P_ZR) + q0) * D + kb * 64 + F.lane;
#pragma unroll
            for (int j = 0; j < 32; ++j) dst[(size_t)j * D] = f2bf(acc[j]);
            continue; }
        r -= I_FOLD;
        {
            v4u* dst = (v4u*)((bf16*)(ws + WS_WMI) + (size_t)l * NPC * D + (size_t)(P_PAD + r) * D);
#pragma unroll
            for (int j = 0; j < 4; ++j) dst[F.lane + 64 * j] = (v4u){0u, 0u, 0u, 0u}; }
    }
    const int gt = F.bid * NTHR + F.tid, NGT = F.G * NTHR;
    bf16* W1 = (bf16*)(ws + WS_SMALL + SM_W1); bf16* W2 = (bf16*)(ws + WS_SMALL + SM_W2);
    for (int i = gt; i < 128 * 128; i += NGT) {
        const int m = i >> 7, k = i & 127, ro = m >> 6, k1 = m & 63, ri = k >> 6, s1 = k & 63; const float ph = (float)((k1 * s1) & 63) * (1.0f / 64.0f);
        const float cs = __builtin_amdgcn_cosf(ph), sn = __builtin_amdgcn_sinf(ph); const float v = (ro == ri) ? cs : (ro == 0 ? sn : -sn);
        W1[i] = f2bf(v * 0.125f); }
    for (int i = gt; i < 128 * 256; i += NGT) {
        const int k2 = i >> 8, k = i & 255, ri = k >> 7, s2 = k & 127; const float ph = (float)((k2 * s2) & 127) * (1.0f / 128.0f);
        W2[i] = f2bf((ri ? __builtin_amdgcn_sinf(ph) : __builtin_amdgcn_cosf(ph)) * 0.08838834764831845f); }
    bf16* WAT = (bf16*)(ws + WS_SMALL + SM_WAT); bf16* WXT = (bf16*)(ws + WS_SMALL + SM_WXT);
    for (int i = gt; i < NLAYER * 2 * 8 * 4096; i += NGT) {
        const int mat = i >> 12, j = (i >> 6) & 63, ii = i & 63; const size_t src = (size_t)mat * 4096 + ii * 64 + j;
        WAT[i] = f2bf(A.lru_wa[src]); WXT[i] = f2bf(A.lru_wx[src]); }
    float* SPT = (float*)(ws + WS_SMALL + SM_SPT);
    for (int i = gt; i < NLAYER * 2 * 512; i += NGT) SPT[i] = log1pf(__expf(-A.lru_lam[i]));
}
DI void prologue_b(const Frame& F, const float* b_ada, const float* g_pre, const float* g_post) {
    const float* modp = (const float*)(F.ws + WS_MODP);
    float* premul = (float*)(F.ws + WS_VEC); float* preadd = premul + VEC_ELEMS; float* postmul = preadd + VEC_ELEMS;
    const int gt = F.bid * NTHR + F.tid, NGT = F.G * NTHR;
    for (int i = gt; i < (int)VEC_ELEMS; i += NGT) {
        const int d = i % D, s = (i / D) % NSEQ, lj = i / (D * NSEQ), l = lj / 3, j = lj % 3;
        float v[3];
#pragma unroll
        for (int t = 0; t < 3; ++t) { const int col = (j * 3 + t) * D + d; float a = b_ada[(size_t)l * NADA + col];
            for (int ks = 0; ks < MOD_KS; ++ks) a += modp[((size_t)(l * MOD_KS + ks) * NSEQ + s) * NADA + col];
            v[t] = a; }
        premul[i] = g_pre[lj * D + d] * (1.0f + v[1]); preadd[i] = v[0]; postmul[i] = (j == 1 ? 1.0f : 0.5f) * v[2] * g_post[lj * D + d];
    }
}
struct X16 { bf16* lo; bf16* hi; int split; };
DI bf16* x16_row(const X16& X, int m) { return m < X.split ? X.lo + (size_t)m * D : X.hi + (size_t)(m - X.split) * D; }
template <bool HAS_G, int XIN>
struct NormIn { v4u g[4]; v4u xb[4]; f32x4 xf[XIN == 0 ? 8 : 1]; };
template <bool HAS_G, int XIN>
DI void norm_load(NormIn<HAS_G, XIN>& I, int m, int lane, const float* xp, const float* xs, const X16& xi, const bf16* Gs) {
    if (XIN == 0) { const float* xr = m < SEQ ? xp + (size_t)m * D : xs + (size_t)(m - SEQ) * D;
#pragma unroll
        for (int j = 0; j < 4; ++j) { I.xf[2 * j] = *(const f32x4*)(xr + 8 * lane + 512 * j); I.xf[2 * j + 1] = *(const f32x4*)(xr + 8 * lane + 512 * j + 4); } }
    else { const bf16* xr = x16_row(xi, m);
#pragma unroll
        for (int j = 0; j < 4; ++j) I.xb[j] = *(const v4u*)(xr + 8 * lane + 512 * j); }
    if (HAS_G) {
#pragma unroll
        for (int j = 0; j < 4; ++j) I.g[j] = *(const v4u*)(Gs + (size_t)m * D + 8 * lane + 512 * j); }
}
template <bool HAS_G, int XIN, int XOUT, bool WRITE_H>
DI void norm_rows(const Frame& F, const float* xp, const float* xs, const X16 xi, const X16 xo, float* out, const bf16* Gs, bf16* H, const float* postmul, const float* premul, const float* preadd, const float pscale = 1.0f) {
    LAS float* VPM = (LAS float*)F.lds; LAS float* VNM = VPM + D; LAS float* VNA = VNM + D;
    const bool lds_vec = (SEQ % F.NGW) == 0; int s_staged = -1;
    NormIn<HAS_G, XIN> nx;
    if (F.gw < M) norm_load<HAS_G, XIN>(nx, F.gw, F.lane, xp, xs, xi, Gs);
#pragma unroll 1
    for (int m = F.gw; m < M; m += F.NGW) {
        const int s = m / SEQ;
        const NormIn<HAS_G, XIN> cu = nx;
        if (m + F.NGW < M) norm_load<HAS_G, XIN>(nx, m + F.NGW, F.lane, xp, xs, xi, Gs);
        if (lds_vec && s != s_staged) {
            LDS_BARRIER();
            for (int i = F.tid; i < D / 4; i += NTHR) { if (HAS_G) *(LAS f32x4*)(VPM + 4 * i) = *(const f32x4*)(postmul + (size_t)s * D + 4 * i);
                if (WRITE_H) { *(LAS f32x4*)(VNM + 4 * i) = *(const f32x4*)(premul + (size_t)s * D + 4 * i); *(LAS f32x4*)(VNA + 4 * i) = *(const f32x4*)(preadd + (size_t)s * D + 4 * i); } }
            LDS_BARRIER(); s_staged = s; }
        f32x4 x[4][2];
#pragma unroll
        for (int j = 0; j < 4; ++j) {
            if (XIN == 0) { x[j][0] = cu.xf[XIN == 0 ? 2 * j : 0]; x[j][1] = cu.xf[XIN == 0 ? 2 * j + 1 : 0]; }
            else { const v4u w = cu.xb[j]; x[j][0] = (f32x4){bflo(w.x), bfhi(w.x), bflo(w.y), bfhi(w.y)}; x[j][1] = (f32x4){bflo(w.z), bfhi(w.z), bflo(w.w), bfhi(w.w)}; } }
        if (HAS_G) {
            f32x4 o[4][2]; float ss = 0.f;
#pragma unroll
            for (int j = 0; j < 4; ++j) { const v4u w = cu.g[j];
                o[j][0] = (f32x4){bflo(w.x), bfhi(w.x), bflo(w.y), bfhi(w.y)}; o[j][1] = (f32x4){bflo(w.z), bfhi(w.z), bflo(w.w), bfhi(w.w)};
#pragma unroll
                for (int h = 0; h < 2; ++h) ss += (o[j][h][0] * o[j][h][0] + o[j][h][1] * o[j][h][1]) + (o[j][h][2] * o[j][h][2] + o[j][h][3] * o[j][h][3]); }
            const float rinv = pscale * __builtin_amdgcn_rsqf(wave_sum(ss) * (1.0f / D) + EPS);
            const float* pm = postmul + (size_t)s * D;
#pragma unroll
            for (int j = 0; j < 4; ++j)
#pragma unroll
                for (int h = 0; h < 2; ++h) { const f32x4 p = lds_vec ? *(const LAS f32x4*)(VPM + 8 * F.lane + 512 * j + 4 * h) : *(const f32x4*)(pm + 8 * F.lane + 512 * j + 4 * h); x[j][h] += p * (o[j][h] * rinv); }
        }
        if (XOUT == 1) { bf16* xw = x16_row(xo, m);
#pragma unroll
            for (int j = 0; j < 4; ++j) { v4u w; w.x = pk2(x[j][0][0], x[j][0][1]); w.y = pk2(x[j][0][2], x[j][0][3]); w.z = pk2(x[j][1][0], x[j][1][1]); w.w = pk2(x[j][1][2], x[j][1][3]);
                *(v4u*)(xw + 8 * F.lane + 512 * j) = w; } }
        if (XOUT == 2) {
#pragma unroll
            for (int j = 0; j < 4; ++j) { *(f32x4*)(out + (size_t)m * D + 8 * F.lane + 512 * j) = x[j][0]; *(f32x4*)(out + (size_t)m * D + 8 * F.lane + 512 * j + 4) = x[j][1]; } }
        if (WRITE_H) {
            float ss = 0.f;
#pragma unroll
            for (int j = 0; j < 4; ++j)
#pragma unroll
                for (int h = 0; h < 2; ++h) ss += (x[j][h][0] * x[j][h][0] + x[j][h][1] * x[j][h][1]) + (x[j][h][2] * x[j][h][2] + x[j][h][3] * x[j][h][3]);
            const float rinv = __builtin_amdgcn_rsqf(wave_sum(ss) * (1.0f / D) + EPS);
            const float* pm = premul + (size_t)s * D; const float* pa = preadd + (size_t)s * D;
#pragma unroll
            for (int j = 0; j < 4; ++j) { f32x4 h0, h1;
                { const f32x4 a = lds_vec ? *(const LAS f32x4*)(VNM + 8 * F.lane + 512 * j) : *(const f32x4*)(pm + 8 * F.lane + 512 * j), b = lds_vec ? *(const LAS f32x4*)(VNA + 8 * F.lane + 512 * j) : *(const f32x4*)(pa + 8 * F.lane + 512 * j); h0 = x[j][0] * rinv * a + b; }
                { const f32x4 a = lds_vec ? *(const LAS f32x4*)(VNM + 8 * F.lane + 512 * j + 4) : *(const f32x4*)(pm + 8 * F.lane + 512 * j + 4), b = lds_vec ? *(const LAS f32x4*)(VNA + 8 * F.lane + 512 * j + 4) : *(const f32x4*)(pa + 8 * F.lane + 512 * j + 4); h1 = x[j][1] * rinv * a + b; }
                v4u w; w.x = pk2(h0[0], h0[1]); w.y = pk2(h0[2], h0[3]); w.z = pk2(h1[0], h1[1]); w.w = pk2(h1[2], h1[3]);
                *(v4u*)(H + (size_t)m * D + 8 * F.lane + 512 * j) = w; }
        }
    }
}
DI void stage_matrix(const Frame& F, const bf16* src, int rows, int cols, int pitch_bytes) {
    const int per_row = cols / 8;
    for (int i = F.tid; i < rows * per_row; i += NTHR) { const int r = i / per_row, c = i % per_row;
        *(LAS v4u*)(F.lds + r * pitch_bytes + c * 16) = *(const v4u*)(src + (size_t)r * cols + c * 8); }
}
DI void fourier_a(const Frame& F) {
    const bf16* P = (const bf16*)(F.ws + WS_U); bf16* FT = (bf16*)(F.ws + WS_FT);
    __syncthreads();
    stage_matrix(F, (const bf16*)(F.ws + WS_SMALL + SM_W1), 128, 128, 272);
    __syncthreads();
    const int l15 = F.lane & 15, quad = F.lane >> 4;
    constexpr int NSL = NZ / 32;
    for (int task = F.gw; task < NSEQ * 128 * NSL; task += F.NGW) {
        const int cs = task % NSL, s2 = (task / NSL) & 127, seq = task / (NSL * 128);
        f32x4 acc[8][2];
#pragma unroll
        for (int a = 0; a < 8; ++a) { acc[a][0] = (f32x4){0.f, 0.f, 0.f, 0.f}; acc[a][1] = (f32x4){0.f, 0.f, 0.f, 0.f}; }
        const bf16* zb = P + (size_t)(seq * SEQ + s2) * NPC + P_ZR + cs * 32 + 2 * l15;
#pragma unroll 2
        for (int kk = 0; kk < 4; ++kk) {
            const int reim = kk >> 1, s1b = (kk & 1) * 32 + quad * 8;
            bf16x8 be, bo; unsigned w[8];
#pragma unroll
            for (int j = 0; j < 8; ++j) w[j] = *(const unsigned*)(zb + (size_t)(s1b + j) * 128 * NPC + reim * NZ);
            split8(w, be, bo);
#pragma unroll
            for (int mt = 0; mt < 8; ++mt) { const bf16x8 a = *(const LAS bf16x8*)(F.lds + (mt * 16 + l15) * 272 + (kk * 32 + quad * 8) * 2);
                acc[mt][0] = mfma16(a, be, acc[mt][0]); acc[mt][1] = mfma16(a, bo, acc[mt][1]); }
        }
#pragma unroll
        for (int mt = 0; mt < 4; ++mt)
#pragma unroll
            for (int r = 0; r < 4; ++r) { const int k1 = mt * 16 + quad * 4 + r; const float ph = (float)((s2 * k1) & 8191) * (1.0f / 8192.0f);
                const float c = __builtin_amdgcn_cosf(ph), s = __builtin_amdgcn_sinf(ph);
                bf16* o = FT + ((((size_t)seq * 64 + k1) * 128 + s2) * 2) * NZ + cs * 32 + 2 * l15;
                const float tr0 = acc[mt][0][r], ti0 = acc[mt + 4][0][r], tr1 = acc[mt][1][r], ti1 = acc[mt + 4][1][r];
                *(unsigned*)o = pk2(tr0 * c + ti0 * s, tr1 * c + ti1 * s);
                *(unsigned*)(o + NZ) = pk2(ti0 * c - tr0 * s, ti1 * c - tr1 * s); }
    }
}
DI void fourier_b(const Frame& F) {
    const bf16* FT = (const bf16*)(F.ws + WS_FT); bf16* Y = (bf16*)(F.ws + WS_H);
    __syncthreads();
    stage_matrix(F, (const bf16*)(F.ws + WS_SMALL + SM_W2), 128, 256, 528);
    __syncthreads();
    const int l15 = F.lane & 15, quad = F.lane >> 4;
    constexpr int NSL = NZ / 32;
    for (int task = F.gw; task < NSEQ * 64 * NSL; task += F.NGW) {
        const int cs = task % NSL, k1 = (task / NSL) & 63, seq = task / (NSL * 64);
        f32x4 acc[8][2];
#pragma unroll
        for (int a = 0; a < 8; ++a) { acc[a][0] = (f32x4){0.f, 0.f, 0.f, 0.f}; acc[a][1] = (f32x4){0.f, 0.f, 0.f, 0.f}; }
        const bf16* tb = FT + (((size_t)seq * 64 + k1) * 128) * 2 * NZ + cs * 32 + 2 * l15;
#pragma unroll 2
        for (int kk = 0; kk < 8; ++kk) {
            const int reim = kk >> 2, s2b = (kk & 3) * 32 + quad * 8;
            bf16x8 be, bo; unsigned w[8];
#pragma unroll
            for (int j = 0; j < 8; ++j) w[j] = *(const unsigned*)(tb + ((size_t)(s2b + j) * 2 + reim) * NZ);
            split8(w, be, bo);
#pragma unroll
            for (int mt = 0; mt < 8; ++mt) { const bf16x8 a = *(const LAS bf16x8*)(F.lds + (mt * 16 + l15) * 528 + (kk * 32 + quad * 8) * 2);
                acc[mt][0] = mfma16(a, be, acc[mt][0]); acc[mt][1] = mfma16(a, bo, acc[mt][1]); }
        }
        const int q = cs * 32 + 2 * l15, g = q >> 6, j = q & 63;
        bf16* yrow = Y + (size_t)seq * SEQ * D;
#pragma unroll
        for (int mt = 0; mt < 8; ++mt)
#pragma unroll
            for (int r = 0; r < 4; ++r) { const int k = k1 + 64 * (mt * 16 + quad * 4 + r), km = (SEQ - k) & (SEQ - 1); const float v0 = acc[mt][0][r], v1 = acc[mt][1][r];
                if (cs < 8) { *(unsigned*)(yrow + (size_t)k * D + g * 128 + j) = pk2(v0, v1);
                    bf16* ym = yrow + (size_t)km * D + g * 128 + 127 - j; ym[0] = f2bf(v1); if (j > 0) ym[1] = f2bf(v0); }
                else if (l15 < 2) { yrow[(size_t)k * D + (2 * l15) * 128 + 64] = f2bf(v0); yrow[(size_t)k * D + (2 * l15 + 1) * 128 + 64] = f2bf(v1); } }
    }
}

typedef short s16x4 __attribute__((ext_vector_type(4)));
DI v2u lds_tr16(LAS unsigned char* p) { const s16x4 v = __builtin_amdgcn_ds_read_tr16_b64_v4i16((LAS s16x4*)p); return __builtin_bit_cast(v2u, v); }
constexpr int G1W_REG = 16384;
DI int g1w_img(int c, int t, int u) { return c * 128 + (((t ^ ((c >> 1) & 3)) << 2) + u) * 8; }
DI int g1w_vimg(int row, int blk) { return row * 256 + ((blk ^ (row & 7)) << 5); }
template <int VAR = 0>
DI void gla_g1(const Frame& F, const float* w_alpha  , const float* b_alpha  ) {
    const bf16* P = (const bf16*)(F.ws + WS_U); bf16* OI = (bf16*)(F.ws + WS_OI); bf16* LS = (bf16*)(F.ws + WS_LS); bf16* QD = (bf16*)(F.ws + WS_QD); float* DD = (float*)(F.ws + WS_DD);
    constexpr int NITEM = NSEQ * 4 * 128 * 2;
    LDS_BARRIER();
#pragma unroll 1
    for (int item = F.NGW - 1 - F.gw; item < NITEM; item += F.NGW) {
    int lane_ = F.lane; asm volatile("" : "+v"(lane_));
    const int l15 = lane_ & 15, quad = lane_ >> 4, q4 = l15 >> 2, p4 = l15 & 3;
    LAS unsigned char* W = F.lds + F.wave * G1W_REG;
    bf16x8 sel[2];
#pragma unroll
    for (int e = 0; e < 2; ++e) { const bool on = quad == 2 * e + (l15 >> 3); const int jj = l15 & 7; const unsigned word = (jj & 1) ? 0x3F800000u : 0x00003F80u;
        v4u w; w.x = (on && (jj >> 1) == 0) ? word : 0u; w.y = (on && (jj >> 1) == 1) ? word : 0u; w.z = (on && (jj >> 1) == 2) ? word : 0u; w.w = (on && (jj >> 1) == 3) ? word : 0u; sel[e] = mk8(w); }
        const int dir = item & 1, cn = (item >> 1) & 127, h = (item >> 8) & 3, seq = item >> 10;
        const size_t m0 = (size_t)seq * SEQ + cn * 64;
        v4u al[4];
#pragma unroll
        for (int t = 0; t < 4; ++t) { const int tau = 16 * t + l15; const bf16* row = P + (m0 + (dir ? 63 - tau : tau)) * NPC;
            const v4u a = *(const v4u*)(row + P_AL + dir * 16 + 8 * (quad & 1)); al[t] = quad < 2 ? a : (v4u){0u, 0u, 0u, 0u}; }
        f32x4 z[4][4];
        {   bf16x8 wh[4], wl[4]; float ba[4];
#pragma unroll
            for (int ct = 0; ct < 4; ++ct) { const int c = 16 * ct + l15; float w[8];
#pragma unroll
                for (int j = 0; j < 8; ++j) { const float v = w_alpha[(dir * 16 + 8 * (quad & 1) + j) * 256 + h * 64 + c]; w[j] = quad < 2 ? v : 0.f; }
                v4u hw, lw;
                hw.x = pk2(w[0], w[1]); hw.y = pk2(w[2], w[3]); hw.z = pk2(w[4], w[5]); hw.w = pk2(w[6], w[7]);
                lw.x = pk2(w[0] - bflo(hw.x), w[1] - bfhi(hw.x)); lw.y = pk2(w[2] - bflo(hw.y), w[3] - bfhi(hw.y)); lw.z = pk2(w[4] - bflo(hw.z), w[5] - bfhi(hw.z)); lw.w = pk2(w[6] - bflo(hw.w), w[7] - bfhi(hw.w));
                wh[ct] = mk8(hw); wl[ct] = mk8(lw); ba[ct] = b_alpha[dir * 256 + h * 64 + c]; }
#pragma unroll
            for (int t = 0; t < 4; ++t)
#pragma unroll
                for (int ct = 0; ct < 4; ++ct) { f32x4 a = (f32x4){ba[ct], ba[ct], ba[ct], ba[ct]}; a = mfma16(mk8(al[t]), wh[ct], a); z[t][ct] = mfma16(mk8(al[t]), wl[ct], a); } }
        __builtin_amdgcn_sched_barrier(0);
        v4u qa[4][2], ka[4][2];
#pragma unroll
        for (int t = 0; t < 4; ++t) { const int tau = 16 * t + l15; const bf16* row = P + (m0 + (dir ? 63 - tau : tau)) * NPC;
#pragma unroll
            for (int kk = 0; kk < 2; ++kk) { qa[t][kk] = *(const v4u*)(row + P_Q + h * 64 + 32 * kk + 8 * quad); ka[t][kk] = *(const v4u*)(row + P_K + h * 64 + 32 * kk + 8 * quad); } }
        __builtin_amdgcn_sched_barrier(0);
        float run[4] = {0.f, 0.f, 0.f, 0.f};
#pragma unroll
        for (int t = 0; t < 4; ++t)
#pragma unroll
            for (int ct = 0; ct < 4; ++ct) { const f32x4 zz = z[t][ct];
                const float p0 = logsigmoid_f(zz[0]) * (1.0f / 16.0f), p1 = p0 + logsigmoid_f(zz[1]) * (1.0f / 16.0f), p2 = p1 + logsigmoid_f(zz[2]) * (1.0f / 16.0f), p3 = p2 + logsigmoid_f(zz[3]) * (1.0f / 16.0f);
                const float s0 = __shfl(p3, l15), s1 = __shfl(p3, l15 + 16), s2 = __shfl(p3, l15 + 32), s3 = __shfl(p3, l15 + 48);
                const float base = run[ct] + ((quad > 0 ? s0 : 0.f) + (quad > 1 ? s1 : 0.f) + (quad > 2 ? s2 : 0.f));
                z[t][ct] = (f32x4){base + p0, base + p1, base + p2, base + p3}; run[ct] += (s0 + s1) + (s2 + s3); }
        float dtot[4];
#pragma unroll
        for (int ct = 0; ct < 4; ++ct) dtot[ct] = __expf(run[ct]);
        if (quad == 0) {
#pragma unroll
            for (int ct = 0; ct < 4; ++ct) DD[(size_t)item * 64 + 16 * ct + l15] = dtot[ct]; }
        v2u ktr[4][4];
#pragma unroll
        for (int t = 0; t < 4; ++t)
#pragma unroll
            for (int ct = 0; ct < 4; ++ct) { const f32x4 zero = (f32x4){0.f, 0.f, 0.f, 0.f};
                const f32x4 qc = mfma16(mk8(qa[t][ct >> 1]), sel[ct & 1], zero), kc = mfma16(mk8(ka[t][ct >> 1]), sel[ct & 1], zero);
                float qt[4], kt[4];
#pragma unroll
                for (int r = 0; r < 4; ++r) { const float e1 = __expf(z[t][ct][r] - run[ct]), e2 = __builtin_amdgcn_rcpf(e1); qt[r] = qc[r] * 0.125f * e1; kt[r] = kc[r] * e2;
                    const int tau = 16 * t + 4 * quad + r, trow = dir ? 63 - tau : tau;
                    QD[((size_t)dir * M + m0 + trow) * 256 + h * 64 + 16 * ct + l15] = f2bf(qt[r] * dtot[ct]); }
                const v2u qp = (v2u){pk2(qt[0], qt[1]), pk2(qt[2], qt[3])}, kp = (v2u){pk2(kt[0], kt[1]), pk2(kt[2], kt[3])};
                ktr[t][ct] = kp; const int off = g1w_img(16 * ct + l15, t, quad);
                *(LAS v2u*)(W + off) = kp; *(LAS v2u*)(W + 8192 + off) = qp; }
        __builtin_amdgcn_sched_barrier(0);
        v4u vv[16];
#pragma unroll
        for (int i = 0; i < 16; ++i) { const int tau = 4 * i + quad; vv[i] = *(const v4u*)(P + (m0 + (dir ? 63 - tau : tau)) * NPC + P_V + h * 128 + 8 * l15); }
        asm volatile("" ::: "memory");
        bf16x8 pf[4][2];
        {   bf16x8 kf[4][2];
#pragma unroll
            for (int si = 0; si < 4; ++si)
#pragma unroll
                for (int kk = 0; kk < 2; ++kk) kf[si][kk] = mk8(lds_tr16(W + g1w_img(32 * kk + 4 * quad + q4, si, p4)), lds_tr16(W + g1w_img(32 * kk + 16 + 4 * quad + q4, si, p4)));
#pragma unroll
            for (int ti = 0; ti < 4; ++ti) { bf16x8 qf[2]; f32x4 sc[4];
#pragma unroll
                for (int kk = 0; kk < 2; ++kk) qf[kk] = mk8(lds_tr16(W + 8192 + g1w_img(32 * kk + 4 * quad + q4, ti, p4)), lds_tr16(W + 8192 + g1w_img(32 * kk + 16 + 4 * quad + q4, ti, p4)));
#pragma unroll
                for (int si = 0; si < 4; ++si) { sc[si] = (f32x4){0.f, 0.f, 0.f, 0.f};
                    if (si <= ti) { sc[si] = mfma16(kf[si][0], qf[0], sc[si]); sc[si] = mfma16(kf[si][1], qf[1], sc[si]);
                        if (si == ti) {
#pragma unroll
                            for (int r = 0; r < 4; ++r) if (quad * 4 + r > l15) sc[si][r] = 0.f; } } }
#pragma unroll
                for (int k2 = 0; k2 < 2; ++k2) { v4u w; w.x = pk2(sc[2 * k2][0], sc[2 * k2][1]); w.y = pk2(sc[2 * k2][2], sc[2 * k2][3]); w.z = pk2(sc[2 * k2 + 1][0], sc[2 * k2 + 1][1]); w.w = pk2(sc[2 * k2 + 1][2], sc[2 * k2 + 1][3]); pf[ti][k2] = mk8(w); } } }
        asm volatile("" ::: "memory");
        __builtin_amdgcn_sched_barrier(0);
#pragma unroll
        for (int i = 0; i < 16; ++i) { const int tau = 4 * i + quad; *(LAS v4u*)(W + g1w_vimg(tau, l15 >> 1) + 16 * (l15 & 1)) = vv[i]; }
        asm volatile("" ::: "memory");
#pragma unroll
        for (int dt = 0; dt < 8; ++dt) { bf16x8 vt[2];
#pragma unroll
            for (int k2 = 0; k2 < 2; ++k2) { const int r0 = 32 * k2 + 4 * quad + q4; vt[k2] = mk8(lds_tr16(W + g1w_vimg(r0, dt) + 8 * p4), lds_tr16(W + g1w_vimg(r0 + 16, dt) + 8 * p4)); }
#pragma unroll
            for (int ti = 0; ti < 4; ++ti) { f32x4 acc = (f32x4){0.f, 0.f, 0.f, 0.f}; acc = mfma16(vt[0], pf[ti][0], acc); if (ti >= 2) acc = mfma16(vt[1], pf[ti][1], acc);
                *(v2u*)(OI + (((size_t)item * 4 + ti) * 8 + dt) * 256 + lane_ * 4) = (v2u){pk2(acc[0], acc[1]), pk2(acc[2], acc[3])}; }
#pragma unroll
            for (int ct = 0; ct < 4; ++ct) { f32x4 acc = (f32x4){0.f, 0.f, 0.f, 0.f};
#pragma unroll
                for (int k2 = 0; k2 < 2; ++k2) acc = mfma16(mk8(ktr[2 * k2][ct], ktr[2 * k2 + 1][ct]), vt[k2], acc);
                *(v2u*)(LS + (size_t)item * 8192 + ((dt * 4 + ct) * 64 + lane_) * 4) = (v2u){pk2(acc[0], acc[1]), pk2(acc[2], acc[3])}; } }
        asm volatile("" ::: "memory");
    }
}
DI void gla_g2(const Frame& F) {
    bf16* LS = (bf16*)(F.ws + WS_LS); const float* DD = (const float*)(F.ws + WS_DD);
    for (int it = F.NGW - 1 - F.gw; it < NSEQ * 4 * 2 * 32; it += F.NGW) {
        const int blk = it & 31, chain = it >> 5, dir = chain & 1, sh = chain >> 1;
        const int e = blk * 256 + F.lane * 4, cc = (blk & 3) * 16 + (F.lane >> 4) * 4;
        f32x4 S = (f32x4){0.f, 0.f, 0.f, 0.f};
#pragma unroll 1
        for (int sb = 0; sb < 128; sb += 8) {
            v2u w[8]; f32x4 dv[8];
#pragma unroll
            for (int u = 0; u < 8; ++u) { const int st = sb + u, cn = dir ? 127 - st : st; const size_t item = ((size_t)sh * 128 + cn) * 2 + dir;
                w[u] = *(const v2u*)(LS + item * 8192 + e); dv[u] = *(const f32x4*)(DD + item * 64 + cc); }
#pragma unroll
            for (int u = 0; u < 8; ++u) { const int st = sb + u, cn = dir ? 127 - st : st; const size_t item = ((size_t)sh * 128 + cn) * 2 + dir;
                *(v2u*)(LS + item * 8192 + e) = (v2u){pk2(S[0], S[1]), pk2(S[2], S[3])};
                S = dv[u] * S + (f32x4){bflo(w[u].x), bfhi(w[u].x), bflo(w[u].y), bfhi(w[u].y)}; }
        }
    }
}
DI void gla_g3(const Frame& F, const float* norm_g  ) {
    const bf16* P = (const bf16*)(F.ws + WS_U); const bf16* OI = (const bf16*)(F.ws + WS_OI); const bf16* LS = (const bf16*)(F.ws + WS_LS); const bf16* QD = (const bf16*)(F.ws + WS_QD); bf16* Y = (bf16*)(F.ws + WS_H);
    const int l15 = F.lane & 15, quad = F.lane >> 4;
    for (int task = F.gw; task < NSEQ * 4 * 128 * 4; task += F.NGW) {
        const int ti = task & 3, cn = (task >> 2) & 127, h = (task >> 9) & 3, seq = task >> 11;
        const size_t m = (size_t)seq * SEQ + cn * 64 + ti * 16 + l15;
        const size_t item0 = ((size_t)(seq * 4 + h) * 128 + cn) * 2;
        v2u oa[8], ob[8], og[8], qf[2][2][2], sf[8][2][2];
#pragma unroll
        for (int dt = 0; dt < 8; ++dt) { oa[dt] = *(const v2u*)(OI + ((item0 * 4 + ti) * 8 + dt) * 256 + F.lane * 4); ob[dt] = *(const v2u*)(OI + (((item0 + 1) * 4 + (3 - ti)) * 8 + dt) * 256 + (quad * 16 + 15 - l15) * 4);
            og[dt] = *(const v2u*)(P + m * NPC + P_OG + h * 128 + dt * 16 + quad * 4); }
#pragma unroll
        for (int dir = 0; dir < 2; ++dir) { const bf16* qd = QD + ((size_t)dir * M + m) * 256 + h * 64 + quad * 4;
#pragma unroll
            for (int kk = 0; kk < 2; ++kk) { qf[dir][kk][0] = *(const v2u*)(qd + kk * 32); qf[dir][kk][1] = *(const v2u*)(qd + kk * 32 + 16); } }
        f32x4 acc[8];
#pragma unroll
        for (int dir = 0; dir < 2; ++dir) { const bf16* ls = LS + (item0 + dir) * 8192 + F.lane * 4;
#pragma unroll
            for (int dt = 0; dt < 8; ++dt)
#pragma unroll
                for (int kk = 0; kk < 2; ++kk) { sf[dt][kk][0] = *(const v2u*)(ls + (dt * 4 + 2 * kk) * 256); sf[dt][kk][1] = *(const v2u*)(ls + (dt * 4 + 2 * kk + 1) * 256); }
            __builtin_amdgcn_sched_barrier(0);
            if (dir == 0) {
#pragma unroll
                for (int dt = 0; dt < 8; ++dt) acc[dt] = (f32x4){bflo(oa[dt].x) + bflo(ob[dt].x), bfhi(oa[dt].x) + bfhi(ob[dt].x), bflo(oa[dt].y) + bflo(ob[dt].y), bfhi(oa[dt].y) + bfhi(ob[dt].y)}; }
#pragma unroll
            for (int kk = 0; kk < 2; ++kk) { const bf16x8 bq = mk8(qf[dir][kk][0], qf[dir][kk][1]);
#pragma unroll
                for (int dt = 0; dt < 8; ++dt) acc[dt] = mfma16(mk8(sf[dt][kk][0], sf[dt][kk][1]), bq, acc[dt]); }
            __builtin_amdgcn_sched_barrier(0); }
        float ss = 0.f;
#pragma unroll
        for (int dt = 0; dt < 8; ++dt) ss += (acc[dt][0] * acc[dt][0] + acc[dt][1] * acc[dt][1]) + (acc[dt][2] * acc[dt][2] + acc[dt][3] * acc[dt][3]);
        ss += __shfl_xor(ss, 16); ss += __shfl_xor(ss, 32);
        const float rinv = __builtin_amdgcn_rsqf(ss * (1.0f / 128.0f) + EPS);
#pragma unroll
        for (int dt = 0; dt < 8; ++dt) { const v2u g = og[dt]; const f32x4 ng = *(const f32x4*)(norm_g + dt * 16 + quad * 4);
            const float y0 = acc[dt][0] * rinv * ng[0] * bflo(g.x), y1 = acc[dt][1] * rinv * ng[1] * bfhi(g.x), y2 = acc[dt][2] * rinv * ng[2] * bflo(g.y), y3 = acc[dt][3] * rinv * ng[3] * bfhi(g.y);
            *(v2u*)(Y + m * D + 512 + h * 128 + dt * 16 + quad * 4) = (v2u){pk2(y0, y1), pk2(y2, y3)}; }
    }
}

constexpr int LR_CW = 0, LR_CB = 16384, LR_WW = 20480, LR_WSTRIDE = 10496, LR_T = 8192;
constexpr int LRU_NCH = SEQ / 64;
constexpr size_t LRU_AU_OFF = (size_t)M * D / 2;
constexpr size_t LCAR_OFF = (size_t)NSEQ * 2 * LRU_NCH * 2 * 512;
struct LruArgs { const float *conv_w, *conv_b, *b_a, *b_x; };
template <bool PASS2>
DI void lru_pass(const Frame& F, const LruArgs& A, int layer) {
    const bf16* P = (const bf16*)(F.ws + WS_U); bf16* Y = (bf16*)(F.ws + WS_H); float* LSUM = (float*)(F.ws + WS_LSUM); unsigned* AU = (unsigned*)(F.out + LRU_AU_OFF);
    const bf16* WAT = (const bf16*)(F.ws + WS_SMALL + SM_WAT); const bf16* WXT = (const bf16*)(F.ws + WS_SMALL + SM_WXT); const float* SPT = (const float*)(F.ws + WS_SMALL + SM_SPT) + layer * 1024;
    LAS float* CW = (LAS float*)(F.lds + LR_CW); LAS float* CB = (LAS float*)(F.lds + LR_CB);
    __syncthreads();
    for (int i = F.tid; i < 2 * 4 * 512; i += NTHR) CW[i] = A.conv_w[i];
    for (int i = F.tid; i < 2 * 512; i += NTHR) CB[i] = A.conv_b[i];
    __syncthreads();
    const int l15 = F.lane & 15, quad = F.lane >> 4;
    for (int task = F.gw; task < NSEQ * LRU_NCH * 8; task += F.NGW) {
        const int blk = task & 7, cq = (task >> 3) & (LRU_NCH - 1), seq = task >> 10;
        const int t0 = cq * 64; const size_t mrow0 = (size_t)seq * SEQ;
#pragma unroll 1
        for (int dir = 0; dir < 2; ++dir) {
            const size_t wb = ((size_t)(layer * 2 + dir) * 8 + blk) * 4096;
            LAS unsigned char* ww = F.lds + LR_WW + F.wave * LR_WSTRIDE;
#pragma unroll
            for (int i = 0; i < 8; ++i) { const int ci = i * 64 + F.lane, row = ci >> 3, ch = ci & 7;
                *(LAS v4u*)(ww + row * 128 + ((ch ^ (row & 7)) << 4)) = *(const v4u*)(WXT + wb + ci * 8); }
            bf16x8 wa[4][2];
#pragma unroll
            for (int jt = 0; jt < 4; ++jt)
#pragma unroll
                for (int kk = 0; kk < 2; ++kk) wa[jt][kk] = *(const bf16x8*)(WAT + wb + (jt * 16 + l15) * 64 + kk * 32 + quad * 8);
            float ba[4], bx[4], sp[4];
#pragma unroll
            for (int jt = 0; jt < 4; ++jt) { const int ch = dir * 512 + blk * 64 + jt * 16 + l15; ba[jt] = A.b_a[ch]; bx[jt] = A.b_x[ch]; sp[jt] = -8.0f * SPT[ch]; }
            float carry[4], atot[4];
#pragma unroll
            for (int jt = 0; jt < 4; ++jt) { carry[jt] = 0.f; atot[jt] = 1.f; }
            if (PASS2) {
                const float* cp = LSUM + LCAR_OFF + ((size_t)((seq * 2 + dir) * LRU_NCH + cq)) * 512 + blk * 64 + l15;
#pragma unroll
                for (int jt = 0; jt < 4; ++jt) carry[jt] = cp[jt * 16];
            }
            v4u xr[2][4], xn[2][4];
            { const int tt0 = dir ? 3 : 0, tq = t0 + tt0 * 16 + l15;
#pragma unroll
              for (int kk = 0; kk < 2; ++kk)
#pragma unroll
                  for (int k = 0; k < 4; ++k) { const int tr = dir ? tq + 3 - k : tq - 3 + k; xr[kk][k] = (v4u){0u, 0u, 0u, 0u};
                      if (tr >= 0 && tr < SEQ) xr[kk][k] = *(const v4u*)(P + (mrow0 + tr) * NPC + P_RI + blk * 64 + kk * 32 + quad * 8); } }
#pragma unroll 1
            for (int ts = 0; ts < 4; ++ts) {
                const int tt = dir ? 3 - ts : ts, tb = t0 + tt * 16, t = tb + l15;
                if (ts < 3) { const int tqn = t0 + (dir ? 2 - ts : ts + 1) * 16 + l15;
#pragma unroll
                    for (int kk = 0; kk < 2; ++kk)
#pragma unroll
                        for (int k = 0; k < 4; ++k) { const int tr = dir ? tqn + 3 - k : tqn - 3 + k; xn[kk][k] = (v4u){0u, 0u, 0u, 0u};
                            if (tr >= 0 && tr < SEQ) xn[kk][k] = *(const v4u*)(P + (mrow0 + tr) * NPC + P_RI + blk * 64 + kk * 32 + quad * 8); } }
                bf16x8 af[2];
#pragma unroll
                for (int kk = 0; kk < 2; ++kk) { const int chb = blk * 64 + kk * 32 + quad * 8;
                    f32x4 x0 = *(const LAS f32x4*)(CB + dir * 512 + chb), x1 = *(const LAS f32x4*)(CB + dir * 512 + chb + 4);
#pragma unroll
                    for (int k = 0; k < 4; ++k) { const v4u w = xr[kk][k];
                        const f32x4 w0 = *(const LAS f32x4*)(CW + (dir * 4 + k) * 512 + chb), w1 = *(const LAS f32x4*)(CW + (dir * 4 + k) * 512 + chb + 4);
                        x0 += w0 * (f32x4){bflo(w.x), bfhi(w.x), bflo(w.y), bfhi(w.y)}; x1 += w1 * (f32x4){bflo(w.z), bfhi(w.z), bflo(w.w), bfhi(w.w)}; }
                    af[kk] = mk8((v4u){pk2(x0[0], x0[1]), pk2(x0[2], x0[3]), pk2(x1[0], x1[1]), pk2(x1[2], x1[3])}); }
#pragma unroll
                for (int jt = 0; jt < 4; ++jt) {
                    f32x4 ga = (f32x4){0.f, 0.f, 0.f, 0.f}, gx = (f32x4){0.f, 0.f, 0.f, 0.f};
#pragma unroll
                    for (int kk = 0; kk < 2; ++kk) { const int row = jt * 16 + l15, off = row * 128 + (((kk * 4 + quad) ^ (row & 7)) << 4);
                        ga = mfma16(af[kk], wa[jt][kk], ga); gx = mfma16(af[kk], *(const LAS bf16x8*)(ww + off), gx); }
                    const int ee = (jt & 1) * 16 + l15 - quad * 8; v4u idw;
                    idw.x = (ee == 0 ? 0x3f80u : 0u) | (ee == 1 ? 0x3f800000u : 0u); idw.y = (ee == 2 ? 0x3f80u : 0u) | (ee == 3 ? 0x3f800000u : 0u);
                    idw.z = (ee == 4 ? 0x3f80u : 0u) | (ee == 5 ? 0x3f800000u : 0u); idw.w = (ee == 6 ? 0x3f80u : 0u) | (ee == 7 ? 0x3f800000u : 0u);
                    const f32x4 xi = mfma16(af[jt >> 1], mk8(idw), (f32x4){0.f, 0.f, 0.f, 0.f});
                    float av[4], uv[4], lav[4];
#pragma unroll
                    for (int r = 0; r < 4; ++r) { const float rg = sigm(ga[r] + ba[jt]), ig = sigm(gx[r] + bx[jt]); const float la = rg * sp[jt];
                        lav[r] = la; av[r] = __expf(la); uv[r] = __builtin_amdgcn_sqrtf(fmaxf(1.0f - av[r] * av[r], 0.f)) * (ig * xi[r]); }
                    if (!PASS2) *(v4u*)(AU + ((((size_t)(task * 2 + dir) * 4 + tt) * 4 + jt) * 64 + F.lane) * 4) = (v4u){pk2(lav[0], lav[1]), pk2(lav[2], lav[3]), pk2(uv[0], uv[1]), pk2(uv[2], uv[3])};
                    float pp[4], hh[4]; float pa = 1.f, hl = 0.f;
#pragma unroll
                    for (int i = 0; i < 4; ++i) { const int r = dir ? 3 - i : i; hl = av[r] * hl + uv[r]; pa *= av[r]; pp[r] = pa; hh[r] = hl; }
                    float cin = carry[jt], tout = carry[jt], ptile = 1.f;
#pragma unroll
                    for (int i = 0; i < 4; ++i) { const int q = dir ? 3 - i : i; const float qa = __shfl(pa, l15 + 16 * q), qh = __shfl(hl, l15 + 16 * q);
                        const bool before = dir ? (q > quad) : (q < quad); if (before) cin = qa * cin + qh; tout = qa * tout + qh; ptile *= qa; }
                    carry[jt] = tout; atot[jt] *= ptile;
                    if (jt == 1) __builtin_amdgcn_sched_barrier(0);
                    if (PASS2) {
                        float hf[4];
#pragma unroll
                        for (int r = 0; r < 4; ++r) hf[r] = hh[r] + pp[r] * cin;
#pragma unroll
                        for (int r = 0; r < 4; ++r) *(LAS bf16*)(ww + LR_T + (quad * 4 + r) * 144 + (jt * 16 + l15) * 2) = f2bf(hf[r]);
                    }
                }
                if (PASS2) {
                    const int tok = F.lane >> 2, part = F.lane & 3; bf16* yp = Y + (mrow0 + tb + tok) * D + 1024 + blk * 64 + part * 16;
                    const v4u t0v = *(const LAS v4u*)(ww + LR_T + tok * 144 + part * 32), t1v = *(const LAS v4u*)(ww + LR_T + tok * 144 + part * 32 + 16);
                    if (dir == 0) { *(v4u*)yp = t0v; *(v4u*)(yp + 8) = t1v; }
                    else { const bf16* gp = P + (mrow0 + tb + tok) * NPC + P_RG + blk * 64 + part * 16;
                        const v4u f0 = *(const v4u*)yp, f1 = *(const v4u*)(yp + 8), g0 = *(const v4u*)gp, g1 = *(const v4u*)(gp + 8);
                        v4u o0, o1;
                        o0.x = pk2((bflo(f0.x) + bflo(t0v.x)) * bflo(g0.x), (bfhi(f0.x) + bfhi(t0v.x)) * bfhi(g0.x)); o0.y = pk2((bflo(f0.y) + bflo(t0v.y)) * bflo(g0.y), (bfhi(f0.y) + bfhi(t0v.y)) * bfhi(g0.y));
                        o0.z = pk2((bflo(f0.z) + bflo(t0v.z)) * bflo(g0.z), (bfhi(f0.z) + bfhi(t0v.z)) * bfhi(g0.z)); o0.w = pk2((bflo(f0.w) + bflo(t0v.w)) * bflo(g0.w), (bfhi(f0.w) + bfhi(t0v.w)) * bfhi(g0.w));
                        o1.x = pk2((bflo(f1.x) + bflo(t1v.x)) * bflo(g1.x), (bfhi(f1.x) + bfhi(t1v.x)) * bfhi(g1.x)); o1.y = pk2((bflo(f1.y) + bflo(t1v.y)) * bflo(g1.y), (bfhi(f1.y) + bfhi(t1v.y)) * bfhi(g1.y));
                        o1.z = pk2((bflo(f1.z) + bflo(t1v.z)) * bflo(g1.z), (bfhi(f1.z) + bfhi(t1v.z)) * bfhi(g1.z)); o1.w = pk2((bflo(f1.w) + bflo(t1v.w)) * bflo(g1.w), (bfhi(f1.w) + bfhi(t1v.w)) * bfhi(g1.w));
                        *(v4u*)yp = o0; *(v4u*)(yp + 8) = o1; }
                }
#pragma unroll
                for (int kk = 0; kk < 2; ++kk)
#pragma unroll
                    for (int k = 0; k < 4; ++k) xr[kk][k] = xn[kk][k];
            }
            if (!PASS2 && quad == 0) { float* s = LSUM + ((size_t)((seq * 2 + dir) * LRU_NCH + cq) * 2) * 512 + blk * 64 + l15;
#pragma unroll
                for (int jt = 0; jt < 4; ++jt) { s[jt * 16] = atot[jt]; s[512 + jt * 16] = carry[jt]; } }
        }
    }
}

DI void lru_out(const Frame& F) {
    const bf16* P = (const bf16*)(F.ws + WS_U); bf16* Y = (bf16*)(F.ws + WS_H); const float* LSUM = (const float*)(F.ws + WS_LSUM); const unsigned* AU = (const unsigned*)(F.out + LRU_AU_OFF);
    const int l15 = F.lane & 15, quad = F.lane >> 4;
    LAS unsigned char* tt_lds = F.lds + F.wave * 4096;
    for (int task = F.gw; task < NSEQ * LRU_NCH * 8; task += F.NGW) {
        const int blk = task & 7, cq = (task >> 3) & (LRU_NCH - 1), seq = task >> 10;
        const int t0 = cq * 64; const size_t mrow0 = (size_t)seq * SEQ;
#pragma unroll 1
        for (int dir = 0; dir < 2; ++dir) {
            float carry[4];
            { const float* cp = LSUM + LCAR_OFF + ((size_t)((seq * 2 + dir) * LRU_NCH + cq)) * 512 + blk * 64 + l15;
#pragma unroll
              for (int jt = 0; jt < 4; ++jt) carry[jt] = cp[jt * 16]; }
            v4u cur[4], nxt[4];
            { const int tt0 = dir ? 3 : 0;
#pragma unroll
              for (int jt = 0; jt < 4; ++jt) cur[jt] = *(const v4u*)(AU + ((((size_t)(task * 2 + dir) * 4 + tt0) * 4 + jt) * 64 + F.lane) * 4); }
#pragma unroll 1
            for (int ts = 0; ts < 4; ++ts) {
                const int tt = dir ? 3 - ts : ts, tb = t0 + tt * 16;
                const int tok = F.lane >> 2, part = F.lane & 3; bf16* yp = Y + (mrow0 + tb + tok) * D + 1024 + blk * 64 + part * 16;
                v4u f0 = (v4u){0u, 0u, 0u, 0u}, f1 = f0, g0 = f0, g1 = f0;
                if (dir == 1) { const bf16* gp = P + (mrow0 + tb + tok) * NPC + P_RG + blk * 64 + part * 16; f0 = *(const v4u*)yp; f1 = *(const v4u*)(yp + 8); g0 = *(const v4u*)gp; g1 = *(const v4u*)(gp + 8); }
                if (ts < 3) { const int ttn = dir ? 2 - ts : ts + 1;
#pragma unroll
                    for (int jt = 0; jt < 4; ++jt) nxt[jt] = *(const v4u*)(AU + ((((size_t)(task * 2 + dir) * 4 + ttn) * 4 + jt) * 64 + F.lane) * 4); }
#pragma unroll
                for (int jt = 0; jt < 4; ++jt) {
                    const v4u w = cur[jt];
                    float av[4], uv[4];
                    av[0] = __expf(bflo(w.x)); av[1] = __expf(bfhi(w.x)); av[2] = __expf(bflo(w.y)); av[3] = __expf(bfhi(w.y));
                    uv[0] = bflo(w.z); uv[1] = bfhi(w.z); uv[2] = bflo(w.w); uv[3] = bfhi(w.w);
                    float pp[4], hh[4]; float pa = 1.f, hl = 0.f;
#pragma unroll
                    for (int i = 0; i < 4; ++i) { const int r = dir ? 3 - i : i; hl = av[r] * hl + uv[r]; pa *= av[r]; pp[r] = pa; hh[r] = hl; }
                    float cin = carry[jt], tout = carry[jt];
#pragma unroll
                    for (int i = 0; i < 4; ++i) { const int q = dir ? 3 - i : i; const float qa = __shfl(pa, l15 + 16 * q), qh = __shfl(hl, l15 + 16 * q);
                        const bool before = dir ? (q > quad) : (q < quad); if (before) cin = qa * cin + qh; tout = qa * tout + qh; }
                    carry[jt] = tout;
#pragma unroll
                    for (int r = 0; r < 4; ++r) *(LAS bf16*)(tt_lds + (quad * 4 + r) * 144 + (jt * 16 + l15) * 2) = f2bf(hh[r] + pp[r] * cin);
                }
                const v4u t0v = *(const LAS v4u*)(tt_lds + tok * 144 + part * 32), t1v = *(const LAS v4u*)(tt_lds + tok * 144 + part * 32 + 16);
                if (dir == 0) { *(v4u*)yp = t0v; *(v4u*)(yp + 8) = t1v; }
                else { v4u o0, o1;
                    o0.x = pk2((bflo(f0.x) + bflo(t0v.x)) * bflo(g0.x), (bfhi(f0.x) + bfhi(t0v.x)) * bfhi(g0.x)); o0.y = pk2((bflo(f0.y) + bflo(t0v.y)) * bflo(g0.y), (bfhi(f0.y) + bfhi(t0v.y)) * bfhi(g0.y));
                    o0.z = pk2((bflo(f0.z) + bflo(t0v.z)) * bflo(g0.z), (bfhi(f0.z) + bfhi(t0v.z)) * bfhi(g0.z)); o0.w = pk2((bflo(f0.w) + bflo(t0v.w)) * bflo(g0.w), (bfhi(f0.w) + bfhi(t0v.w)) * bfhi(g0.w));
                    o1.x = pk2((bflo(f1.x) + bflo(t1v.x)) * bflo(g1.x), (bfhi(f1.x) + bfhi(t1v.x)) * bfhi(g1.x)); o1.y = pk2((bflo(f1.y) + bflo(t1v.y)) * bflo(g1.y), (bfhi(f1.y) + bfhi(t1v.y)) * bfhi(g1.y));
                    o1.z = pk2((bflo(f1.z) + bflo(t1v.z)) * bflo(g1.z), (bfhi(f1.z) + bfhi(t1v.z)) * bfhi(g1.z)); o1.w = pk2((bflo(f1.w) + bflo(t1v.w)) * bflo(g1.w), (bfhi(f1.w) + bfhi(t1v.w)) * bfhi(g1.w));
                    *(v4u*)yp = o0; *(v4u*)(yp + 8) = o1; }
#pragma unroll
                for (int jt = 0; jt < 4; ++jt) cur[jt] = nxt[jt];
            }
        }
    }
}

DI void lru_carry_scan(const Frame& F) {
    float* LSUM = (float*)(F.ws + WS_LSUM); float* LCAR = LSUM + LCAR_OFF;
    for (int it = F.gw - F.NGW / 2; it < NSEQ * 2 * 8; it += F.NGW) { if (it < 0) continue;
        const int blk = it & 7, sd = it >> 3, dir = sd & 1; const int ch = blk * 64 + F.lane;
        float car = 0.f;
#pragma unroll 1
        for (int pb = 0; pb < LRU_NCH; pb += 16) { float a[16], h[16];
#pragma unroll
            for (int u = 0; u < 16; ++u) { const int p = pb + u, cq = dir ? LRU_NCH - 1 - p : p; const float* s = LSUM + ((size_t)(sd * LRU_NCH + cq) * 2) * 512 + ch; a[u] = s[0]; h[u] = s[512]; }
#pragma unroll
            for (int u = 0; u < 16; ++u) { const int p = pb + u, cq = dir ? LRU_NCH - 1 - p : p; LCAR[((size_t)(sd * LRU_NCH + cq)) * 512 + ch] = car; car = a[u] * car + h[u]; } }
    }
}

constexpr int CF_W = 0, CF_B = 63488, CF_G = 65536, CF_LB = 67584;
DI void conformer(const Frame& F, const float* dw_w  , const float* dw_b, const float* ln_g, const float* ln_b) {
    const bf16* P = (const bf16*)(F.ws + WS_U); bf16* Y = (bf16*)(F.ws + WS_H);
    LAS float* W = (LAS float*)(F.lds + CF_W); LAS float* B = (LAS float*)(F.lds + CF_B); LAS float* LG = (LAS float*)(F.lds + CF_G); LAS float* LB = (LAS float*)(F.lds + CF_LB);
    __syncthreads();
    for (int i = F.tid; i < 31 * 512; i += NTHR) W[i] = dw_w[i];
    { B[F.tid] = dw_b[F.tid]; LG[F.tid] = ln_g[F.tid]; LB[F.tid] = ln_b[F.tid]; }
    __syncthreads();
    const int c0 = F.lane * 8;
    for (int task = F.NGW - 1 - F.gw; task < NSEQ * (SEQ / 8); task += F.NGW) {
        const int seq = task / (SEQ / 8), t0 = (task % (SEQ / 8)) * 8; const size_t mrow0 = (size_t)seq * SEQ;
        f32x4 acc[8][2];
        { const f32x4 b0 = *(const LAS f32x4*)(B + c0), b1 = *(const LAS f32x4*)(B + c0 + 4);
#pragma unroll
          for (int tt = 0; tt < 8; ++tt) { acc[tt][0] = b0; acc[tt][1] = b1; } }
        f32x4 ww0[8], ww1[8];
#pragma unroll
        for (int s = 0; s < 8; ++s) { ww0[s] = (f32x4){0.f, 0.f, 0.f, 0.f}; ww1[s] = (f32x4){0.f, 0.f, 0.f, 0.f}; }
#pragma unroll 1
        for (int ib = 0; ib < 40; ib += 8) {
            v4u uw[8];
#pragma unroll
            for (int ii = 0; ii < 8; ++ii) { const int i = ib + ii, t = t0 - 15 + i; uw[ii] = (v4u){0u, 0u, 0u, 0u};
                if (i < 38 && t >= 0 && t < SEQ) uw[ii] = *(const v4u*)(P + (mrow0 + t) * NPC + P_CV + c0); }
#pragma unroll
            for (int ii = 0; ii < 8; ++ii) { const int i = ib + ii;
                ww0[ii] = (f32x4){0.f, 0.f, 0.f, 0.f}; ww1[ii] = (f32x4){0.f, 0.f, 0.f, 0.f};
                if (i <= 30) { ww0[ii] = *(const LAS f32x4*)(W + i * 512 + c0); ww1[ii] = *(const LAS f32x4*)(W + i * 512 + c0 + 4); }
                const f32x4 u0 = (f32x4){bflo(uw[ii].x), bfhi(uw[ii].x), bflo(uw[ii].y), bfhi(uw[ii].y)}, u1 = (f32x4){bflo(uw[ii].z), bfhi(uw[ii].z), bflo(uw[ii].w), bfhi(uw[ii].w)};
#pragma unroll
                for (int tt = 0; tt < 8; ++tt) { acc[tt][0] += ww0[(ii - tt) & 7] * u0; acc[tt][1] += ww1[(ii - tt) & 7] * u1; } }
        }
        const f32x4 g0 = *(const LAS f32x4*)(LG + c0), g1 = *(const LAS f32x4*)(LG + c0 + 4), lb0 = *(const LAS f32x4*)(LB + c0), lb1 = *(const LAS f32x4*)(LB + c0 + 4);
#pragma unroll
        for (int tt = 0; tt < 8; ++tt) {
            float s = (acc[tt][0][0] + acc[tt][0][1]) + (acc[tt][0][2] + acc[tt][0][3]) + (acc[tt][1][0] + acc[tt][1][1]) + (acc[tt][1][2] + acc[tt][1][3]);
            const float mean = wave_sum(s) * (1.0f / 512.0f);
            const f32x4 d0 = acc[tt][0] - mean, d1 = acc[tt][1] - mean;
            float q = (d0[0] * d0[0] + d0[1] * d0[1]) + (d0[2] * d0[2] + d0[3] * d0[3]) + (d1[0] * d1[0] + d1[1] * d1[1]) + (d1[2] * d1[2] + d1[3] * d1[3]);
            const float rstd = __builtin_amdgcn_rsqf(wave_sum(q) * (1.0f / 512.0f) + EPS);
            const f32x4 y0 = d0 * rstd * g0 + lb0, y1 = d1 * rstd * g1 + lb1;
            v4u o; o.x = pk2(silu_f(y0[0]), silu_f(y0[1])); o.y = pk2(silu_f(y0[2]), silu_f(y0[3])); o.z = pk2(silu_f(y1[0]), silu_f(y1[1])); o.w = pk2(silu_f(y1[2]), silu_f(y1[3]));
            *(v4u*)(Y + (mrow0 + t0 + tt) * D + 1536 + c0) = o;
            __builtin_amdgcn_sched_barrier(0); }
    }
}
constexpr int NPH = 3 + NLAYER * 4 * 5;
static inline bool phase_exists(int p) { if (p < 3) return true; const int q = p - 3, it = (q / 5) % 4, slot = q % 5; if (slot == 0) return it == 0 || it == 3; if (slot >= 3) return it == 1; return true; }
#ifndef DUP_MASK
#define DUP_MASK 0
#endif
#ifndef DUP_SUB
#define DUP_SUB 15
#endif
#ifndef G_ALIGN
#define G_ALIGN true
#endif
#ifndef G_SP2
#define G_SP2 true
#endif
#ifndef WGM_BF
#define WGM_BF 8
#endif
#ifndef WGM_UP
#define WGM_UP 8
#endif
#ifndef MK_ONE_LAUNCH
#define MK_ONE_LAUNCH 1
#endif
struct Args { const float* in[28]; float* out; unsigned char* ws; int ph_lo, ph_hi, one_launch, pad; };
DI int opaque_i(int k) { asm volatile("" : "+s"(k)); return k; }
#define IN(k) (args.in[opaque_i(k)])
__global__ void __launch_bounds__(NTHR, 2) fwd_kernel(Args args) {
    extern __shared__ __attribute__((aligned(16))) unsigned char lds_raw[];
#define MKFRAME() Frame F; { int t_ = threadIdx.x; asm volatile("" : "+v"(t_)); unsigned char* w_ = args.ws; asm volatile("" : "+s"(w_)); float* o_ = args.out; asm volatile("" : "+s"(o_)); \
        F.lds = (LAS unsigned char*)lds_raw; F.tid = t_; F.lane = t_ & 63; F.wave = __builtin_amdgcn_readfirstlane(t_ >> 6); \
        F.bid = blockIdx.x; F.G = gridDim.x; F.gw = F.bid * NWAVES + F.wave; F.NGW = F.G * NWAVES; F.out = o_; F.ws = w_; }
    volatile LAS unsigned* MISC = (volatile LAS unsigned*)((LAS unsigned char*)lds_raw + MISC_OFF);
    if (threadIdx.x < 64) MISC[threadIdx.x] = 0u;
    __syncthreads();
    unsigned* ctl = (unsigned*)(args.ws + WS_CTL);
    XcdBarrier bar; bar.bar = ctl + CW_BAR; bar.x = 0; bar.st = nullptr;
    if (args.one_launch) bar = xcd_barrier_post(ctl + CW_BAR, MISC + 8);
    const int lo = args.ph_lo, hi = args.ph_hi;
    bool need_bar = false;
#define RUN(p) (lo <= (p) && (p) < hi)
#define PRE_BAR() do { if (need_bar) xcd_barrier(bar); need_bar = (args.one_launch != 0); } while (0)
#define PREMUL ((const float*)(F.ws + WS_VEC))
#define PREADD (PREMUL + VEC_ELEMS)
#define POSTMUL (PREMUL + 2 * VEC_ELEMS)
#define Hb ((bf16*)(F.ws + WS_H))
#define Ub ((bf16*)(F.ws + WS_U))
#define Gb ((bf16*)(F.ws + WS_G))

    if (RUN(0)) { PRE_BAR(); MKFRAME();
        ProArgs A{IN(2), IN(3), IN(4), IN(8), IN(9), IN(10), IN(11), IN(12), IN(27), IN(18), IN(20), IN(22)};
        prologue_a(F, A); }
    if (RUN(1)) { PRE_BAR(); MKFRAME(); prologue_b(F, IN(5), IN(6), IN(7)); }
    if (RUN(2)) { PRE_BAR(); MKFRAME(); const X16 xn{nullptr, nullptr, 0}; norm_rows<false, 0, 0, true>(F, IN(0), IN(1), xn, xn, F.out, nullptr, Hb, nullptr, PREMUL, PREADD); }

    int dup = 0;
#pragma unroll 1
    for (int li = 0; li < NLAYER * 4; ++li) {
        const int l = li >> 2, it = li & 3, base = 3 + li * 5;
        const bool dp = DUP_MASK != 0 && dup != 0;
#define SLOT_ON(s) (!dp || ((DUP_MASK >> (s)) & 1))
#ifdef SKIP_MIX
        if (it == 1 || it == 2) continue;
#endif
        if ((it == 0 || it == 3) && RUN(base) && SLOT_ON(0)) { PRE_BAR(); MKFRAME();
            const int f = it == 3;
            pg8::Gemm g{Hb, (const bf16*)(F.ws + WS_WUP) + (size_t)(l * 2 + f) * NUP * D, M, NUP, D}; pg8::StaticOrder S; S.init(M, NUP, F.G, F.bid, WGM_UP);
            pg8::EpiSwiGLU E{Ub, DFF};
#if defined(EXP_SAMETILE)
            if (dp) { pg8::SameTileOrder S2; S2.init(M, NUP, F.G, F.bid); pg8::gemm_phase<pg8::EpiSwiGLU, pg8::SameTileOrder, true, true>(F.lds, g, S2, E, F.tid); } else
#endif
            pg8::gemm_phase<pg8::EpiSwiGLU, pg8::StaticOrder, G_ALIGN, G_SP2>(F.lds, g, S, E, F.tid); }
        if (RUN(base + 1) && SLOT_ON(1)) { PRE_BAR(); MKFRAME();
            pg8::Gemm g; pg8::EpiBf16 E;
            if (it == 1) { g = pg8::Gemm{Hb, (const bf16*)(F.ws + WS_WMI) + (size_t)l * NPC * D, M, NPC, D}; E = pg8::EpiBf16{Ub, NPC, 1}; }
            else if (it == 2) { g = pg8::Gemm{Hb, (const bf16*)(F.ws + WS_WMO) + (size_t)l * D * D, M, D, D}; E = pg8::EpiBf16{Gb, D, 0}; }
            else { g = pg8::Gemm{Ub, (const bf16*)(F.ws + WS_WDN) + (size_t)(l * 2 + (it == 3)) * D * DFF, M, D, DFF}; E = pg8::EpiBf16{Gb, D, 0}; }
            pg8::StaticOrder S; S.init(g.M, g.N, F.G, F.bid, WGM_BF);
#if defined(EXP_SAMETILE2)
            if (dp) { pg8::SameTileOrder S2; S2.init(g.M, g.N, F.G, F.bid); pg8::gemm_phase<pg8::EpiBf16, pg8::SameTileOrder, G_ALIGN, G_SP2>(F.lds, g, S2, E, F.tid); } else
#endif
            pg8::gemm_phase<pg8::EpiBf16, pg8::StaticOrder, G_ALIGN, G_SP2>(F.lds, g, S, E, F.tid); }
        if (it == 1) {
            if (RUN(base + 2) && SLOT_ON(2)) { PRE_BAR(); MKFRAME();
                if (!dp || (DUP_SUB & 1)) fourier_a(F);
                if (dp && (DUP_SUB & 16)) gla_g1<1>(F, IN(13) + (size_t)l * 2 * 16 * 256, IN(14) + (size_t)l * 2 * 256);
                if (dp && (DUP_SUB & 64)) gla_g1<3>(F, IN(13) + (size_t)l * 2 * 16 * 256, IN(14) + (size_t)l * 2 * 256);
                if (dp && (DUP_SUB & 32)) gla_g1<2>(F, IN(13) + (size_t)l * 2 * 16 * 256, IN(14) + (size_t)l * 2 * 256);
                if (!dp || (DUP_SUB & 2)) gla_g1(F, IN(13) + (size_t)l * 2 * 16 * 256, IN(14) + (size_t)l * 2 * 256);
                LruArgs LA{IN(16) + (size_t)l * 2 * 4 * 512, IN(17) + (size_t)l * 2 * 512, IN(19) + (size_t)l * 2 * 512, IN(21) + (size_t)l * 2 * 512};
                if (!dp || (DUP_SUB & 4)) lru_pass<false>(F, LA, l);
                __syncthreads();
                if (!dp || (DUP_SUB & 8)) conformer(F, IN(23) + (size_t)l * 31 * 512, IN(24) + (size_t)l * 512, IN(25) + (size_t)l * 512, IN(26) + (size_t)l * 512); }
            if (RUN(base + 3) && SLOT_ON(3)) { PRE_BAR(); MKFRAME();
                if (!dp || (DUP_SUB & 1)) fourier_b(F);
                if (!dp) gla_g2(F);
                lru_carry_scan(F); }
            if (RUN(base + 4) && SLOT_ON(4)) { PRE_BAR(); MKFRAME();
                if (!dp || (DUP_SUB & 2)) gla_g3(F, IN(15) + (size_t)l * 128);
                LruArgs LA{IN(16) + (size_t)l * 2 * 4 * 512, IN(17) + (size_t)l * 2 * 512, IN(19) + (size_t)l * 2 * 512, IN(21) + (size_t)l * 2 * 512};
                if (!dp || (DUP_SUB & 4)) { __syncthreads(); lru_out(F); } }
        } else if (RUN(base + 2) && (!dp || ((DUP_MASK >> 5) & 1))) { PRE_BAR(); MKFRAME();
            const int j = it == 0 ? 0 : (it == 2 ? 1 : 2); const int lj = l * 3 + j;
            const float* pm = POSTMUL + (size_t)lj * NSEQ * D;
            const float* nm = PREMUL + (size_t)(lj + 1) * NSEQ * D; const float* na = PREADD + (size_t)(lj + 1) * NSEQ * D;
            const float ps = dp ? 0.f : 1.f;
            const X16 xa{(bf16*)F.out, (bf16*)F.out + (size_t)X16_SPLIT * D, X16_SPLIT}; const X16 xb{(bf16*)(F.ws + WS_WUP), (bf16*)(F.ws + WS_LS), X16_SPLIT};
            if (li == 0 && !dp) norm_rows<true, 0, 1, true>(F, IN(0), IN(1), xa, xa, F.out, Gb, Hb, pm, nm, na);
            else if (li == NLAYER * 4 - 1) norm_rows<true, 1, 2, false>(F, nullptr, nullptr, xb, xb, F.out, Gb, Hb, pm, nullptr, nullptr, ps);
            else if (li == NLAYER * 4 - 2) norm_rows<true, 1, 1, true>(F, nullptr, nullptr, xa, xb, F.out, Gb, Hb, pm, nm, na, ps);
            else norm_rows<true, 1, 1, true>(F, nullptr, nullptr, xa, xa, F.out, Gb, Hb, pm, nm, na, ps); }
#if defined(EXP_BARS)
        if (dp && args.one_launch) { for (int q = 0; q < EXP_BARS; ++q) xcd_barrier(bar); }
#endif
        if (DUP_MASK != 0) { if (!dp) { dup = 1; --li; } else dup = 0; }
    }
#undef SLOT_ON
#undef RUN
#undef PRE_BAR
}

extern "C" void kernel_launch(void* const* d_in, const int* in_sizes, int n_in, void* d_out, int out_size, void* d_ws, size_t ws_size, hipStream_t stream) {
    static int grid = 0;
    if (grid == 0) {
        if (n_in != 28 || out_size != M * D || ws_size < WS_END) { fprintf(stderr, "kernel_launch: unexpected problem (n_in %d, out %d, ws %zu)\n", n_in, out_size, ws_size); grid = -1; return; }
        int dev = 0, cus = 0;
        if (hipGetDevice(&dev) != hipSuccess || hipDeviceGetAttribute(&cus, hipDeviceAttributeMultiprocessorCount, dev) != hipSuccess) { grid = -1; return; }
        if (hipFuncSetAttribute((const void*)fwd_kernel, hipFuncAttributeMaxDynamicSharedMemorySize, LDS_BYTES) != hipSuccess) { fprintf(stderr, "kernel_launch: hipFuncSetAttribute failed\n"); grid = -1; return; }
        int per_cu = 0;
        if (hipOccupancyMaxActiveBlocksPerMultiprocessor(&per_cu, (const void*)fwd_kernel, NTHR, LDS_BYTES) != hipSuccess || per_cu < 1) { fprintf(stderr, "kernel_launch: occupancy query says %d\n", per_cu); }
        (void)hipGetLastError();
        grid = cus;
    }
    if (grid < 0) return;
    (void)hipMemsetAsync((char*)d_ws + WS_CTL, 0, CTL_ZERO_BYTES, stream);
    Args a{};
    for (int i = 0; i < 28; ++i) a.in[i] = (const float*)d_in[i];
    a.out = (float*)d_out; a.ws = (unsigned char*)d_ws; a.pad = 0;
#if MK_ONE_LAUNCH
    a.ph_lo = 0; a.ph_hi = NPH; a.one_launch = 1;
    hipLaunchKernelGGL(fwd_kernel, dim3(grid), dim3(NTHR), LDS_BYTES, stream, a);
#else
    a.one_launch = 0;
    for (int p = 0; p < NPH; ++p) { if (!phase_exists(p)) continue; a.ph_lo = p; a.ph_hi = p + 1;
        hipLaunchKernelGGL(fwd_kernel, dim3(grid), dim3(NTHR), LDS_BYTES, stream, a); }
#endif
}
```

```cpp
#include <hip/hip_runtime.h>
#include <cstdio>
#include <cstdint>
#define MK_ONE_LAUNCH 1
namespace pg8 {
#define PG8_LAS __attribute__((address_space(3)))
typedef unsigned short bf16_t;
typedef short bf16x8 __attribute__((ext_vector_type(8)));
typedef float f32x4 __attribute__((ext_vector_type(4)));
typedef unsigned u32x4 __attribute__((ext_vector_type(4)));
constexpr int BM = 256, BK = 64, HALF = 128, HTB = HALF * BK * 2  , STAGE_BYTES = 8 * HTB, NXCD = 8;

__device__ __forceinline__ int lds_byte(int r, int c) { const int st = (r >> 4) * 2 + (c >> 5), rr = r & 15, cc = c & 31, ob = rr * 64 + cc * 2; return st * 1024 + (ob ^ (((ob >> 9) & 1) << 5)); }
__device__ __forceinline__ void stage_rc(int b, int& R, int& C) { const int st = b / 1024, sb = b % 1024, swz = sb ^ (((sb >> 9) & 1) << 5); R = (st >> 1) * 16 + swz / 64; C = (st & 1) * 32 + (swz % 64) / 2; }
__device__ __forceinline__ int perm32(int rho) { const int n = rho >> 4, i = rho & 15; return 8 * (i >> 2) + 4 * n + (i & 3); }

struct Unit { int pm, pn; };
struct Gemm { const bf16_t* A; const bf16_t* Bt; int M, N, K; };

struct StaticOrder {
    int nM, nN, nwg, G, c, WGM;
    __device__ __forceinline__ void init(int M, int N, int G_, int c_, int wgm = 8) { nM = M / BM; nN = N / BM; nwg = nM * nN; G = G_; c = c_; WGM = wgm; }
    __device__ __forceinline__ bool next(int i, Unit& u) const {
        const long L = (long)i * G + c; if (L >= nwg) return false;
        int wgid = (int)L; { const int q = nwg / NXCD, r = nwg % NXCD, xcd = wgid % NXCD, off = wgid / NXCD; wgid = (xcd < r ? xcd * (q + 1) : r * (q + 1) + (xcd - r) * q) + off; }
        const int nig = WGM * nN, gid = wgid / nig, fm = gid * WGM, gsz = (nM - fm) < WGM ? (nM - fm) : WGM;
        u.pm = fm + ((wgid % nig) % gsz); u.pn = (wgid % nig) / gsz; return true;
    }
    __device__ __forceinline__ void a_ready(const Unit&) const {}
    __device__ __forceinline__ void done(const Unit&) const {}
};

struct SameTileOrder : StaticOrder {
    __device__ __forceinline__ bool next(int i, Unit& u) const { const bool ok = StaticOrder::next(i, u); u.pm = 0; u.pn = 0; return ok; }
};
typedef __bf16 bf16v2_t __attribute__((ext_vector_type(2))); typedef float f32x2_t __attribute__((ext_vector_type(2)));
__device__ __forceinline__ unsigned cvt_pk_bf16(float lo, float hi) { const f32x2_t v = {lo, hi}; const bf16v2_t b = __builtin_convertvector(v, bf16v2_t); return __builtin_bit_cast(unsigned, b); }

#define EPI_STORE(p, v) (*(p) = (v))
struct EpiBf16 {
    static constexpr bool PERM = true, AFTER_DRAIN = false;
    bf16_t* O; int ldc; int mode;
    __device__ __forceinline__ void operator()(const f32x4 (&acc)[2][2][4][2], const Unit& u, int wr, int wc, int fr, int fq) const {
        const int row0 = u.pm * BM + wr * 64 + fr; const int col0 = u.pn * BM + wc * 32 + 8 * fq;
        const int act = mode == 0 ? 0 : ((u.pn == 4 || u.pn == 5) ? 1 : ((u.pn == 8 || u.pn == 9) ? 2 : ((u.pn >= 10 && u.pn < 14) ? 3 : 0)));
        if (act == 3) {
            const int colg = 10 * BM + (u.pn - 10) * HALF + wc * 32 + 8 * fq;
#pragma unroll
            for (int ai = 0; ai < 2; ++ai)
#pragma unroll
                for (int m = 0; m < 4; ++m) { bf16_t* rowp = O + (size_t)(row0 + ai * HALF + m * 16) * ldc + colg; float h[8];
#pragma unroll
                    for (int n = 0; n < 2; ++n)
#pragma unroll
                        for (int j = 0; j < 4; ++j) { const float v = acc[ai][0][m][n][j], g = acc[ai][1][m][n][j]; h[n * 4 + j] = v * __builtin_amdgcn_rcpf(1.0f + __expf(-g)); }
                    u32x4 w; w.x = cvt_pk_bf16(h[0], h[1]); w.y = cvt_pk_bf16(h[2], h[3]); w.z = cvt_pk_bf16(h[4], h[5]); w.w = cvt_pk_bf16(h[6], h[7]);
                    EPI_STORE((u32x4*)rowp, w); }
            return; }
#pragma unroll
        for (int ai = 0; ai < 2; ++ai)
#pragma unroll
            for (int m = 0; m < 4; ++m) { bf16_t* rowp = O + (size_t)(row0 + ai * HALF + m * 16) * ldc + col0;
#pragma unroll
                for (int bj = 0; bj < 2; ++bj) { f32x4 v0 = acc[ai][bj][m][0], v1 = acc[ai][bj][m][1];
                    if (act == 1) {
#pragma unroll
                        for (int j = 0; j < 4; ++j) { v0[j] = v0[j] * __builtin_amdgcn_rcpf(1.0f + __expf(-v0[j])); v1[j] = v1[j] * __builtin_amdgcn_rcpf(1.0f + __expf(-v1[j])); } }
                    if (act == 2) {
#pragma unroll
                        for (int j = 0; j < 4; ++j) { v0[j] = v0[j] * __builtin_amdgcn_rcpf(1.0f + __expf(-1.5957691216f * (v0[j] + 0.044715f * v0[j] * v0[j] * v0[j])));
                            v1[j] = v1[j] * __builtin_amdgcn_rcpf(1.0f + __expf(-1.5957691216f * (v1[j] + 0.044715f * v1[j] * v1[j] * v1[j]))); } }
                    u32x4 w; w.x = cvt_pk_bf16(v0[0], v0[1]); w.y = cvt_pk_bf16(v0[2], v0[3]); w.z = cvt_pk_bf16(v1[0], v1[1]); w.w = cvt_pk_bf16(v1[2], v1[3]);
                    EPI_STORE((u32x4*)(rowp + bj * HALF), w); } }
    }
};
struct EpiSwiGLU {
    static constexpr bool PERM = true, AFTER_DRAIN = false;
    bf16_t* O; int ldc;
    __device__ __forceinline__ void operator()(const f32x4 (&acc)[2][2][4][2], const Unit& u, int wr, int wc, int fr, int fq) const {
        const int row0 = u.pm * BM + wr * 64 + fr; const int col0 = u.pn * HALF + wc * 32 + 8 * fq;
#pragma unroll
        for (int ai = 0; ai < 2; ++ai)
#pragma unroll
            for (int m = 0; m < 4; ++m) { bf16_t* rowp = O + (size_t)(row0 + ai * HALF + m * 16) * ldc + col0;
                float h[8];
#pragma unroll
                for (int n = 0; n < 2; ++n)
#pragma unroll
                    for (int j = 0; j < 4; ++j) { const float up = acc[ai][0][m][n][j], g = acc[ai][1][m][n][j];
                        h[n * 4 + j] = up * g * __builtin_amdgcn_rcpf(1.0f + __builtin_amdgcn_exp2f(g)); }
                u32x4 w; w.x = cvt_pk_bf16(h[0], h[1]); w.y = cvt_pk_bf16(h[2], h[3]); w.z = cvt_pk_bf16(h[4], h[5]); w.w = cvt_pk_bf16(h[6], h[7]);
                EPI_STORE((u32x4*)rowp, w); }
    }
};

template <class Epi, class Sched, bool ALIGN_EPI = false, bool SP2 = false>
__device__ __forceinline__ void gemm_phase(PG8_LAS unsigned char* lds, const Gemm g, const Sched& S, const Epi& E, const int tid) {
    const int wid = __builtin_amdgcn_readfirstlane(tid >> 6), lane = tid & 63, wr = wid >> 2, wc = wid & 3, fr = lane & 15, fq = lane >> 4;
    const int K = g.K, nt = K / BK;
    unsigned voffA[2], voffB[2];
#pragma unroll
    for (int i = 0; i < 2; ++i) { int R, C; stage_rc(tid * 16 + i * 8192, R, C); const int Rb = Epi::PERM ? ((R & ~31) + perm32(R & 31)) : R;
        voffA[i] = (unsigned)(R * K + C) * 2u; voffB[i] = (unsigned)(Rb * K + C) * 2u; }
    const size_t kstep = (size_t)(BK * 2);
    const size_t hstep = (size_t)HALF * K * 2;
    const size_t tstep = 2 * hstep;
    const unsigned ldsw = (unsigned)wid * 1024u;
    const int aoff = lds_byte(wr * 64 + fr, fq * 8), boff = lds_byte(wc * 32 + fr, fq * 8);
#define PG8_SA(b, h) (((b) * 2 + (h)) * HTB)
#define PG8_SB(b, h) ((4 + (b) * 2 + (h)) * HTB)
#define PG8_STAGE(bufoff, gbase, voff) do { _Pragma("unroll") for (int _i = 0; _i < 2; ++_i) \
        __builtin_amdgcn_global_load_lds((const unsigned*)((const char*)(gbase) + (voff)[_i]), (PG8_LAS unsigned*)(lds + (bufoff) + ldsw + _i * 8192), 16, 0, 0); } while (0)
#define PG8_LDA(dst, b, h) do { _Pragma("unroll") for (int m = 0; m < 4; ++m) _Pragma("unroll") for (int k = 0; k < 2; ++k) dst[m][k] = *(const PG8_LAS bf16x8*)(lds + PG8_SA(b, h) + aoff + m * 2048 + k * 1024); } while (0)
#define PG8_LDB(dst, b, h) do { _Pragma("unroll") for (int n = 0; n < 2; ++n) _Pragma("unroll") for (int k = 0; k < 2; ++k) dst[n][k] = *(const PG8_LAS bf16x8*)(lds + PG8_SB(b, h) + boff + n * 2048 + k * 1024); } while (0)
#define PG8_MMA(ai, bj, At, Bt) do { __builtin_amdgcn_s_setprio(1); _Pragma("unroll") for (int m = 0; m < 4; ++m) _Pragma("unroll") for (int n = 0; n < 2; ++n) _Pragma("unroll") for (int k = 0; k < 2; ++k) \
        acc[ai][bj][m][n] = __builtin_amdgcn_mfma_f32_16x16x32_bf16(Bt[n][k], At[m][k], acc[ai][bj][m][n], 0, 0, 0); __builtin_amdgcn_s_setprio(0); } while (0)
#define PG8_WAIT_V(n) asm volatile("s_waitcnt vmcnt(" #n ")" ::: "memory")
#define PG8_WAIT_L(n) asm volatile("s_waitcnt lgkmcnt(" #n ")" ::: "memory")
#define PG8_BAR __builtin_amdgcn_s_barrier()
#define PG8_SCHED __builtin_amdgcn_sched_barrier(0)
    Unit cur, nxt; int ui = 0;
    if (!S.next(0, cur)) return;
    f32x4 acc[2][2][4][2];
#pragma unroll
    for (int a = 0; a < 2; ++a)
#pragma unroll
        for (int b = 0; b < 2; ++b)
#pragma unroll
            for (int m = 0; m < 4; ++m)
#pragma unroll
                for (int n = 0; n < 2; ++n) acc[a][b][m][n] = (f32x4){0.f, 0.f, 0.f, 0.f};
    bf16x8 At[4][2], B0[2][2], B1[2][2];
    const char* cA = (const char*)g.A + (size_t)cur.pm * tstep; const char* cB = (const char*)g.Bt + (size_t)cur.pn * tstep;
    S.a_ready(cur);
    if constexpr (SP2) {
        PG8_STAGE(PG8_SB(0, 0), cB, voffB); PG8_STAGE(PG8_SB(0, 1), cB + hstep, voffB); PG8_STAGE(PG8_SA(0, 0), cA, voffA); PG8_STAGE(PG8_SA(0, 1), cA + hstep, voffA);
        if (wr == 1) PG8_BAR;
        PG8_WAIT_V(2); PG8_BAR;
        PG8_STAGE(PG8_SB(1, 0), cB + kstep, voffB); PG8_STAGE(PG8_SA(1, 0), cA + kstep, voffA); PG8_STAGE(PG8_SB(1, 1), cB + hstep + kstep, voffB);
        PG8_WAIT_V(6); PG8_BAR;
    } else {
        PG8_STAGE(PG8_SB(0, 0), cB, voffB); PG8_STAGE(PG8_SA(0, 0), cA, voffA); PG8_STAGE(PG8_SB(0, 1), cB + hstep, voffB); PG8_STAGE(PG8_SA(0, 1), cA + hstep, voffA);
        if (wr == 1) PG8_BAR;
        PG8_WAIT_V(4); PG8_BAR;
        PG8_STAGE(PG8_SB(1, 0), cB + kstep, voffB); PG8_STAGE(PG8_SA(1, 0), cA + kstep, voffA); PG8_STAGE(PG8_SB(1, 1), cB + hstep + kstep, voffB);
        PG8_WAIT_V(6); PG8_BAR;
    }
    for (;;) {
        const bool has_next = S.next(ui + 1, nxt);
        const char* nA = has_next ? (const char*)g.A + (size_t)nxt.pm * tstep : cA; const char* nB = has_next ? (const char*)g.Bt + (size_t)nxt.pn * tstep : cB;
        for (int t = 0; t < nt; t += 2) {
            const bool last = (t == nt - 2);
            const char* a1 = cA + (size_t)(t + 1) * kstep;
            const char* a2 = last ? nA : cA + (size_t)(t + 2) * kstep; const char* b2 = last ? nB : cB + (size_t)(t + 2) * kstep;
            const char* a3 = a2 + kstep; const char* b3 = b2 + kstep;
            if (last && has_next) S.a_ready(nxt);
            if constexpr (SP2) {
            PG8_LDB(B0, 0, 0); PG8_LDB(B1, 0, 1); PG8_SCHED; PG8_LDA(At, 0, 0); PG8_STAGE(PG8_SA(1, 1), a1 + hstep, voffA);
            PG8_WAIT_V(8); PG8_WAIT_L(0); PG8_BAR; PG8_MMA(0, 0, At, B0); PG8_MMA(0, 1, At, B1); PG8_BAR; PG8_SCHED;
            PG8_LDA(At, 0, 1); PG8_STAGE(PG8_SB(0, 0), b2, voffB); PG8_STAGE(PG8_SB(0, 1), b2 + hstep, voffB); PG8_STAGE(PG8_SA(0, 0), a2, voffA);
            PG8_WAIT_V(8); PG8_WAIT_L(0); PG8_BAR; PG8_MMA(1, 0, At, B0); PG8_MMA(1, 1, At, B1); PG8_BAR; PG8_SCHED;
            PG8_LDB(B0, 1, 0); PG8_LDB(B1, 1, 1); PG8_SCHED; PG8_LDA(At, 1, 0); PG8_STAGE(PG8_SA(0, 1), a2 + hstep, voffA);
            PG8_WAIT_V(8); PG8_WAIT_L(0); PG8_BAR; PG8_MMA(0, 0, At, B0); PG8_MMA(0, 1, At, B1); PG8_BAR; PG8_SCHED;
            PG8_LDA(At, 1, 1); PG8_STAGE(PG8_SB(1, 0), b3, voffB); PG8_STAGE(PG8_SB(1, 1), b3 + hstep, voffB); PG8_STAGE(PG8_SA(1, 0), a3, voffA);
            PG8_WAIT_V(8); PG8_WAIT_L(0); PG8_BAR; PG8_MMA(1, 0, At, B0); PG8_MMA(1, 1, At, B1); PG8_BAR; PG8_SCHED;
            } else {
            PG8_LDB(B0, 0, 0); PG8_SCHED; PG8_LDA(At, 0, 0); PG8_STAGE(PG8_SA(1, 1), a1 + hstep, voffA);
            PG8_WAIT_L(8); PG8_BAR; PG8_WAIT_L(0); PG8_MMA(0, 0, At, B0); PG8_BAR; PG8_SCHED;
            PG8_LDB(B1, 0, 1); PG8_STAGE(PG8_SB(0, 0), b2, voffB);
            PG8_BAR; PG8_WAIT_L(0); PG8_MMA(0, 1, At, B1); PG8_BAR;
            PG8_LDA(At, 0, 1); PG8_STAGE(PG8_SA(0, 0), a2, voffA);
            PG8_BAR; PG8_WAIT_L(0); PG8_MMA(1, 0, At, B0); PG8_BAR; PG8_SCHED;
            PG8_STAGE(PG8_SB(0, 1), b2 + hstep, voffB);
            PG8_WAIT_V(6); PG8_BAR; PG8_MMA(1, 1, At, B1); PG8_BAR;
            PG8_LDB(B0, 1, 0); PG8_SCHED; PG8_LDA(At, 1, 0); PG8_STAGE(PG8_SA(0, 1), a2 + hstep, voffA);
            PG8_WAIT_L(8); PG8_BAR; PG8_WAIT_L(0); PG8_MMA(0, 0, At, B0); PG8_BAR; PG8_SCHED;
            PG8_LDB(B1, 1, 1); PG8_STAGE(PG8_SB(1, 0), b3, voffB);
            PG8_BAR; PG8_WAIT_L(0); PG8_MMA(0, 1, At, B1); PG8_BAR;
            PG8_LDA(At, 1, 1); PG8_STAGE(PG8_SA(1, 0), a3, voffA);
            PG8_BAR; PG8_WAIT_L(0); PG8_MMA(1, 0, At, B0); PG8_BAR; PG8_SCHED;
            PG8_STAGE(PG8_SB(1, 1), b3 + hstep, voffB);
            PG8_WAIT_V(6); PG8_BAR; PG8_MMA(1, 1, At, B1); PG8_BAR;
            }
        }
        if constexpr (ALIGN_EPI) { if (wr == 0) PG8_BAR; }
        if constexpr (!Epi::AFTER_DRAIN) { E(acc, cur, wr, wc, fr, fq); S.done(cur); }
        if (!has_next) break;
#pragma unroll
        for (int a = 0; a < 2; ++a)
#pragma unroll
            for (int b = 0; b < 2; ++b)
#pragma unroll
                for (int m = 0; m < 4; ++m)
#pragma unroll
                    for (int n = 0; n < 2; ++n) acc[a][b][m][n] = (f32x4){0.f, 0.f, 0.f, 0.f};
        cur = nxt; cA = nA; cB = nB; ++ui;
        if constexpr (ALIGN_EPI) { if (wr == 1) PG8_BAR; }
    }
    PG8_WAIT_V(0);
    if constexpr (!ALIGN_EPI) { if (wr == 0) PG8_BAR; }
    PG8_BAR;
#undef PG8_SA
#undef PG8_SB
#undef PG8_STAGE
#undef PG8_LDA
#undef PG8_LDB
#undef PG8_MMA
#undef PG8_WAIT_V
#undef PG8_WAIT_L
#undef PG8_BAR
#undef PG8_SCHED
}
}
constexpr int D = 2048, SEQ = 8192, NSEQ = 5, M = NSEQ * SEQ, DFF = 5632, NUP = 2 * DFF, MIW = 4128, NLAYER = 2, NADA = 9 * D;
constexpr int NPC = 4352;
constexpr int NZ = 288;
constexpr int P_Q = 0, P_K = 256, P_V = 512, P_OG = 1024, P_RI = 1536, P_RG = 2048, P_CV = 2560, P_ZR = 3584, P_ZI = P_ZR + NZ, P_AL = P_ZI + NZ, P_PAD = P_AL + 32;
static_assert(P_PAD == 4192 && P_PAD <= NPC, "P columns");
constexpr float EPS = 1e-6f;
constexpr int NWAVES = 8, NTHR = 512;
constexpr int MOD_KS = 16;

constexpr size_t MiB = 1u << 20;
constexpr size_t WS_CTL = 0, CTL_ZERO_BYTES = 64 * 1024;
constexpr size_t WS_VEC = 1 * MiB;
constexpr size_t VEC_ELEMS = (size_t)NLAYER * 3 * NSEQ * D;
constexpr size_t WS_SMALL = 2 * MiB;
constexpr size_t SM_W1 = 0, SM_W2 = 64 * 1024, SM_WAT = 256 * 1024, SM_WXT = 512 * 1024, SM_SPT = 768 * 1024, SM_WAF = 800 * 1024;
constexpr size_t WS_WUP = 3 * MiB;
constexpr size_t WS_WDN = 179 * MiB;
constexpr size_t WS_WMI = 267 * MiB;
constexpr size_t WS_WMO = 305 * MiB;
constexpr size_t WS_H = 321 * MiB;
constexpr size_t WS_U = 481 * MiB;
constexpr size_t WS_MODP = WS_U;
constexpr size_t WS_QD = 861 * MiB;
constexpr size_t WS_DD = 901 * MiB;
constexpr size_t WS_LSUM = 903 * MiB;
constexpr size_t WS_G = 921 * MiB;
constexpr size_t WS_FT = WS_G;
constexpr size_t WS_OI = WS_G + 80 * MiB;
constexpr size_t WS_LS = 1081 * MiB;
constexpr size_t WS_END = 1161 * MiB;
static_assert(WS_WUP + 4 * (size_t)NUP * D * 2 <= WS_WDN && WS_WDN + 4 * (size_t)D * DFF * 2 <= WS_WMI && WS_WMI + 2 * (size_t)NPC * D * 2 <= WS_WMO && WS_WMO + 2 * (size_t)D * D * 2 <= WS_H, "ws map 1");
static_assert(WS_H + (size_t)M * D * 2 <= WS_U && WS_U + (size_t)M * DFF * 2 <= WS_G && WS_U + (size_t)M * NPC * 2 <= WS_QD && WS_QD + 2 * (size_t)M * 256 * 2 <= WS_DD, "ws map 2");
static_assert(WS_DD + 5120 * 64 * 4 <= WS_LSUM && WS_LSUM + (size_t)NSEQ * 2 * 128 * 3 * 512 * 4 <= WS_G && WS_G + (size_t)M * D * 2 <= WS_LS && WS_LS + (size_t)5120 * 8192 * 2 <= WS_END, "ws map 3");
static_assert(WS_MODP + (size_t)NLAYER * MOD_KS * NSEQ * NADA * 4 <= WS_QD && WS_VEC + 3 * VEC_ELEMS * 4 <= WS_SMALL, "ws map 4");
constexpr int X16_SPLIT = 22528;
static_assert((size_t)X16_SPLIT * D * 2 <= 2 * (size_t)NUP * D * 2 && (size_t)(M - X16_SPLIT) * D * 2 <= 80 * MiB, "x16 parking");
constexpr int CW_BAR = 1024;

constexpr int RING_BYTES = 131072;
constexpr int MISC_OFF = 155648;
constexpr int LDS_BYTES = 159744;

#define DI __device__ __forceinline__
#define LAS __attribute__((address_space(3)))
typedef unsigned short bf16;
typedef unsigned v4u __attribute__((ext_vector_type(4)));
typedef unsigned v2u __attribute__((ext_vector_type(2)));
typedef float f32x4 __attribute__((ext_vector_type(4)));
typedef float f32x2 __attribute__((ext_vector_type(2)));
typedef short bf16x8 __attribute__((ext_vector_type(8)));
#define LDS_WAIT() asm volatile("s_waitcnt lgkmcnt(0)" ::: "memory")
#define LDS_BARRIER() do { asm volatile("s_waitcnt lgkmcnt(0)" ::: "memory"); __builtin_amdgcn_s_barrier(); asm volatile("" ::: "memory"); } while (0)
DI float u2f(unsigned x) { return __builtin_bit_cast(float, x); }
DI float shfl_f(float v, int src) { return __builtin_bit_cast(float, __builtin_amdgcn_ds_bpermute(src << 2, __builtin_bit_cast(int, v))); }
DI float shfl_xor_f(float v, int m) { const int self = (int)__builtin_amdgcn_mbcnt_hi(~0u, __builtin_amdgcn_mbcnt_lo(~0u, 0u)); return shfl_f(v, self ^ m); }
DI void sync_threads() { __builtin_amdgcn_fence(__ATOMIC_RELEASE, "workgroup"); __builtin_amdgcn_s_barrier(); __builtin_amdgcn_fence(__ATOMIC_ACQUIRE, "workgroup"); }
DI float bflo(unsigned w) { return u2f(w << 16); }
DI float bfhi(unsigned w) { return u2f(w & 0xffff0000u); }
DI float bf1(bf16 b) { return u2f((unsigned)b << 16); }
typedef __bf16 bf16v2 __attribute__((ext_vector_type(2)));
DI unsigned pk2(float lo, float hi) { const f32x2 v = {lo, hi}; const bf16v2 b = __builtin_convertvector(v, bf16v2); return __builtin_bit_cast(unsigned, b); }
DI bf16 f2bf(float f) { return (bf16)(pk2(f, 0.f) & 0xffffu); }
DI float sigm(float x) { return __builtin_amdgcn_rcpf(1.0f + __expf(-x)); }
DI float silu_f(float x) { return x * sigm(x); }
DI float gelu_tanh_f(float x) { return x * sigm(1.5957691216f * (x + 0.044715f * x * x * x)); }
DI float logsigmoid_f(float z) { return fminf(z, 0.f) - __logf(1.0f + __expf(-fabsf(z))); }
DI float wave_sum(float v) {
#pragma unroll
    for (int o = 1; o < 64; o <<= 1) v += shfl_xor_f(v, o);
    return v;
}
DI f32x4 mfma16(bf16x8 a, bf16x8 b, f32x4 c) { return __builtin_amdgcn_mfma_f32_16x16x32_bf16(a, b, c, 0, 0, 0); }
DI bf16x8 mk8(v4u w) { return __builtin_bit_cast(bf16x8, w); }
DI bf16x8 mk8(v2u lo, v2u hi) { v4u w; w.x = lo.x; w.y = lo.y; w.z = hi.x; w.w = hi.y; return __builtin_bit_cast(bf16x8, w); }
DI void split8(const unsigned (&w)[8], bf16x8& ev, bf16x8& od) {
    v4u e, o;
    e.x = (w[0] & 0xffffu) | (w[1] << 16); e.y = (w[2] & 0xffffu) | (w[3] << 16); e.z = (w[4] & 0xffffu) | (w[5] << 16); e.w = (w[6] & 0xffffu) | (w[7] << 16);
    o.x = (w[0] >> 16) | (w[1] & 0xffff0000u); o.y = (w[2] >> 16) | (w[3] & 0xffff0000u); o.z = (w[4] >> 16) | (w[5] & 0xffff0000u); o.w = (w[6] >> 16) | (w[7] & 0xffff0000u);
    ev = __builtin_bit_cast(bf16x8, e); od = __builtin_bit_cast(bf16x8, o);
}

#define XB_TMO      128
#define XB_XCNT(j)  (256  + 64 * (j))
#define XB_XSUB(j)  (1280 + 64 * (j))
#define XB_XGEN(j)  (2304 + 64 * (j))
#define XB_TOP      3328
#define XB_TOPGEN   3392
#define XCD_BAR_WORDS 3456
#define XB_SPIN_CAP (1u << 22)
static_assert((CW_BAR + XCD_BAR_WORDS) * 4 <= (int)CTL_ZERO_BYTES, "barrier words inside the memset region");
__device__ __forceinline__ unsigned xb_ld(unsigned* p)              { return __hip_atomic_load(p, __ATOMIC_RELAXED, __HIP_MEMORY_SCOPE_AGENT); }
__device__ __forceinline__ unsigned xb_add(unsigned* p, unsigned v) { return __hip_atomic_fetch_add(p, v, __ATOMIC_RELAXED, __HIP_MEMORY_SCOPE_AGENT); }
__device__ __forceinline__ unsigned xb_xcc_id() { return (unsigned)__builtin_amdgcn_s_getreg((3 << 11) | 20) & 0xFu; }
#define XB_SPIN(cond, bar) do { unsigned _sp = 0; while (cond) { __builtin_amdgcn_s_sleep(1); \
    if ((++_sp & 255u) == 0u) { if (xb_ld(&(bar)[XB_TMO])) break; if (_sp > XB_SPIN_CAP) { atomicAdd(&(bar)[XB_TMO], 1u); break; } } } } while (0)
struct XcdBarrier { unsigned* bar; unsigned x; volatile LAS unsigned* st; };
__device__ __forceinline__ XcdBarrier xcd_barrier_post(unsigned* bar, volatile LAS unsigned* st) {
    XcdBarrier b; b.bar = bar; b.x = xb_xcc_id(); b.st = st;
    if (threadIdx.x == 0) (void)xb_add(&bar[XB_XCNT(b.x)], 1u);
    return b;
}
__device__ __forceinline__ void xcd_barrier_complete(unsigned* bar, unsigned x, unsigned& nloc, unsigned& nx) {
    const unsigned G = gridDim.x * gridDim.y * gridDim.z;
    unsigned sum, cnt, mine, sp = 0u;
    for (;;) {
        sum = 0u; cnt = 0u; mine = 0u;
#pragma unroll
        for (unsigned j = 0; j < 16; ++j) { const unsigned c = xb_ld(&bar[XB_XCNT(j)]); sum += c; cnt += (c > 0u) ? 1u : 0u; mine = (j == x) ? c : mine; }
        if (sum == G) break;
        __builtin_amdgcn_s_sleep(1);
        if ((++sp & 255u) == 0u) { if (xb_ld(&bar[XB_TMO])) break; if (sp > XB_SPIN_CAP) { atomicAdd(&bar[XB_TMO], 1u); break; } }
    }
    nloc = mine > 0u ? mine : 1u; nx = cnt > 0u ? cnt : 1u;
}
__device__ __forceinline__ void xcd_barrier(const XcdBarrier& b) {
    asm volatile("s_waitcnt vmcnt(0)" ::: "memory");
    sync_threads();
    if (threadIdx.x == 0) {
        unsigned* bar = b.bar;
        __builtin_amdgcn_s_waitcnt(0);
        unsigned nloc = b.st[0], nx = b.st[1];
        if (nloc == 0u) { xcd_barrier_complete(bar, b.x, nloc, nx); b.st[0] = nloc; b.st[1] = nx; }
        const unsigned old = xb_add(&bar[XB_XSUB(b.x)], 1u);
        const unsigned gen = old / nloc;
        if (old + 1u == (gen + 1u) * nloc) {
            __builtin_amdgcn_fence(__ATOMIC_RELEASE, "agent");
            asm volatile("s_waitcnt vmcnt(0)" ::: "memory");
            const unsigned og = xb_add(&bar[XB_TOP], 1u);
            const unsigned tg = og / nx;
            if (og + 1u == (tg + 1u) * nx) xb_add(&bar[XB_TOPGEN], 1u);
            else XB_SPIN(xb_ld(&bar[XB_TOPGEN]) == tg, bar);
            __builtin_amdgcn_fence(__ATOMIC_ACQUIRE, "agent");
            xb_add(&bar[XB_XGEN(b.x)], 1u);
            asm volatile("s_waitcnt vmcnt(0)" ::: "memory");
        } else {
            XB_SPIN(xb_ld(&bar[XB_XGEN(b.x)]) == gen, bar);
            __builtin_amdgcn_fence(__ATOMIC_ACQUIRE, "agent");
            asm volatile("s_waitcnt vmcnt(0)" ::: "memory");
        }
    }
    sync_threads();
}

struct Frame {
    LAS unsigned char* lds;
    int tid, lane, wave, bid, G, gw, NGW;
    float* out; unsigned char* ws;
};
DI void transpose_item(const float* W, int Nsrc, int K, bf16* WT, int n0, int k0, int dst_row0, LAS float* scr, int lane, float scale = 1.0f) {
#pragma unroll 8
    for (int i = 0; i < 32; ++i) { const int kk = 2 * i + (lane >> 5); scr[kk * 33 + (lane & 31)] = scale * W[(size_t)(k0 + kk) * Nsrc + n0 + (lane & 31)]; }
    LDS_WAIT(); asm volatile("" ::: "memory");
    const int c = lane & 7;
#pragma unroll
    for (int j = 0; j < 4; ++j) { const int n = (lane >> 3) + 8 * j; const LAS float* s = scr + (8 * c) * 33 + n;
        v4u o; o.x = pk2(s[0 * 33], s[1 * 33]); o.y = pk2(s[2 * 33], s[3 * 33]); o.z = pk2(s[4 * 33], s[5 * 33]); o.w = pk2(s[6 * 33], s[7 * 33]);
        *(v4u*)(WT + (size_t)(dst_row0 + n) * K + k0 + 8 * c) = o; }
    LDS_WAIT(); asm volatile("" ::: "memory");
}
DI int mixin_dst_row(int n) {
    if (n < 768) return P_Q + (n - 512);
    if (n < 1024) return P_K + (n - 768);
    if (n < 1536) return P_V + (n - 1024);
    if (n < 2048) return P_OG + (n - 1536);
    if (n < 2080) return P_AL + (n - 2048);
    if (n < 2592) return P_RI + (n - 2080);
    if (n < 3104) return P_RG + (n - 2592);
    if (n < 3616) { const int j = n - 3104; return P_CV + 256 * (j / 128) + (j % 128); }
    { const int j = n - 3616; return P_CV + 256 * (j / 128) + 128 + (j % 128); }
}
struct ProArgs { const float *c_prompt, *c_sample, *w_ada, *w1in, *w1out, *w2in, *w2out, *wmi, *wmo, *lru_wa, *lru_wx, *lru_lam, *gla_wa; };
DI void prologue_a(const Frame& F, const ProArgs& A) {
    unsigned char* ws = F.ws;
    LAS float* scr = (LAS float*)(F.lds + F.wave * 8704);
    LAS float* sc = (LAS float*)(F.lds + 69632);
    LAS float* ctab = (LAS float*)(F.lds + 69632 + 40960);
    for (int i = F.tid; i < NSEQ * D; i += NTHR) { const float c = i < D ? A.c_prompt[i] : A.c_sample[i - D]; sc[i] = silu_f(c); }
    if (F.tid < 128) ctab[F.tid] = __builtin_amdgcn_cosf((float)F.tid * (1.0f / 128.0f)) * 0.08838834764831845f;
    sync_threads();
    constexpr int I_UP = (D / 64) * (NUP / 32), I_DN = (DFF / 64) * (D / 32), I_MI = (D / 64) * ((MIW - 512) / 32), I_MO = (D / 64) * (D / 32), I_FOLD = 32 * (2 * NZ / 32), I_PAD = NPC - P_PAD, I_MOD = MOD_KS * (NADA / 256);
    constexpr int I_LAYER = 2 * I_UP + 2 * I_DN + I_MI + I_MO + I_FOLD + I_PAD + I_MOD;
    for (int it = F.gw; it < NLAYER * I_LAYER; it += F.NGW) {
        const int l = it / I_LAYER; int r = it - l * I_LAYER;
        if (r < I_MOD) {
            const int ks = r / (NADA / 256), cb = r % (NADA / 256), n = cb * 256 + F.lane * 4;
            const float* wp = A.w_ada + ((size_t)l * D + ks * 128) * NADA + n;
            f32x4 acc[NSEQ];
#pragma unroll
            for (int s = 0; s < NSEQ; ++s) acc[s] = (f32x4){0.f, 0.f, 0.f, 0.f};
#pragma unroll 8
            for (int k = 0; k < 128; ++k) { const f32x4 w = *(const f32x4*)(wp + (size_t)k * NADA);
#pragma unroll
                for (int s = 0; s < NSEQ; ++s) acc[s] += w * sc[s * D + ks * 128 + k]; }
            float* mp = (float*)(ws + WS_MODP) + ((size_t)(l * MOD_KS + ks) * NSEQ) * NADA + n;
#pragma unroll
            for (int s = 0; s < NSEQ; ++s) *(f32x4*)(mp + (size_t)s * NADA) = acc[s];
            continue; }
        r -= I_MOD;
        if (r < 2 * I_UP) {
            const int f = r / I_UP; r -= f * I_UP; const int kb = r / (NUP / 32), nb = r % (NUP / 32), n0 = nb * 32;
            const int j0 = n0 < DFF ? n0 : n0 - DFF, dst = 256 * (j0 / 128) + (n0 < DFF ? 0 : 128) + (j0 % 128);
            transpose_item((f ? A.w2in : A.w1in) + (size_t)l * D * NUP, NUP, D, (bf16*)(ws + WS_WUP) + (size_t)(l * 2 + f) * NUP * D, n0, kb * 64, dst, scr, F.lane, n0 < DFF ? -0.6931471805599453f : -1.4426950408889634f); continue; }
        r -= 2 * I_UP;
        if (r < 2 * I_DN) {
            const int f = r / I_DN; r -= f * I_DN; const int kb = r / (D / 32), nb = r % (D / 32);
            transpose_item((f ? A.w2out : A.w1out) + (size_t)l * DFF * D, D, DFF, (bf16*)(ws + WS_WDN) + (size_t)(l * 2 + f) * D * DFF, nb * 32, kb * 64, nb * 32, scr, F.lane); continue; }
        r -= 2 * I_DN;
        if (r < I_MI) {
            const int kb = r / ((MIW - 512) / 32), nb = r % ((MIW - 512) / 32), n0 = 512 + nb * 32;
            transpose_item(A.wmi + (size_t)l * D * MIW, MIW, D, (bf16*)(ws + WS_WMI) + (size_t)l * NPC * D, n0, kb * 64, mixin_dst_row(n0), scr, F.lane); continue; }
        r -= I_MI;
        if (r < I_MO) {
            const int kb = r / (D / 32), nb = r % (D / 32);
            transpose_item(A.wmo + (size_t)l * D * D, D, D, (bf16*)(ws + WS_WMO) + (size_t)l * D * D, nb * 32, kb * 64, nb * 32, scr, F.lane); continue; }
        r -= I_MO;
        if (r < I_FOLD) {
            constexpr int NRB = 2 * NZ / 32; const int kb = r / NRB, rb = r % NRB, reim = rb / (NZ / 32), q0 = (rb % (NZ / 32)) * 32;
            const float* wbase = A.wmi + (size_t)l * D * MIW + (size_t)(kb * 64 + F.lane) * MIW;
            float acc[32];
#pragma unroll
            for (int j = 0; j < 32; ++j) acc[j] = 0.f;
            if (q0 < 256) {
                const int g = q0 >> 6, cp0 = q0 & 63; const float* wrow = wbase + g * 128;
                for (int c4 = 0; c4 < 32; ++c4) { const f32x4 w = *(const f32x4*)(wrow + c4 * 4);
#pragma unroll
                    for (int e = 0; e < 4; ++e) { const int c = c4 * 4 + e;
#pragma unroll
                        for (int j = 0; j < 32; ++j) acc[j] += w[e] * ctab[(c * (cp0 + j) + reim * 32) & 127]; } }
            } else if (reim == 0) {
                for (int c4 = 0; c4 < 32; ++c4) {
#pragma unroll
                    for (int g = 0; g < 4; ++g) { const f32x4 w = *(const f32x4*)(wbase + g * 128 + c4 * 4); acc[g] += ((w[0] - w[1]) + (w[2] - w[3])) * 0.08838834764831845f; } }
            }
            bf16* dst = (bf16*)(ws + WS_WMI) + (size_t)l * NPC * D + (size_t)((reim ? P_ZI : P_ZR) + q0) * D + kb * 64 + F.lane;
#pragma unroll
            for (int j = 0; j < 32; ++j) dst[(size_t)j * D] = f2bf(acc[j]);
            continue; }
        r -= I_FOLD;
        {
            v4u* dst = (v4u*)((bf16*)(ws + WS_WMI) + (size_t)l * NPC * D + (size_t)(P_PAD + r) * D);
#pragma unroll
            for (int j = 0; j < 4; ++j) dst[F.lane + 64 * j] = (v4u){0u, 0u, 0u, 0u}; }
    }
    const int gt = F.bid * NTHR + F.tid, NGT = F.G * NTHR;
    bf16* W1 = (bf16*)(ws + WS_SMALL + SM_W1); bf16* W2 = (bf16*)(ws + WS_SMALL + SM_W2);
    for (int i = gt; i < 128 * 128; i += NGT) {
        const int m = i >> 7, k = i & 127, ro = m >> 6, k1 = m & 63, ri = k >> 6, s1 = k & 63; const float ph = (float)((k1 * s1) & 63) * (1.0f / 64.0f);
        const float cs = __builtin_amdgcn_cosf(ph), sn = __builtin_amdgcn_sinf(ph); const float v = (ro == ri) ? cs : (ro == 0 ? sn : -sn);
        W1[i] = f2bf(v * 0.125f); }
    for (int i = gt; i < 128 * 256; i += NGT) {
        const int k2 = i >> 8, k = i & 255, ri = k >> 7, s2 = k & 127; const float ph = (float)((k2 * s2) & 127) * (1.0f / 128.0f);
        W2[i] = f2bf((ri ? __builtin_amdgcn_sinf(ph) : __builtin_amdgcn_cosf(ph)) * 0.08838834764831845f); }
    bf16* WAT = (bf16*)(ws + WS_SMALL + SM_WAT); bf16* WXT = (bf16*)(ws + WS_SMALL + SM_WXT);
    for (int i = gt; i < NLAYER * 2 * 8 * 4096; i += NGT) {
        const int mat = i >> 12, j = (i >> 6) & 63, ii = i & 63; const size_t src = (size_t)mat * 4096 + ii * 64 + j;
        WAT[i] = f2bf(-1.4426950408889634f * A.lru_wa[src]); WXT[i] = f2bf(-1.4426950408889634f * A.lru_wx[src]); }
    float* SPT = (float*)(ws + WS_SMALL + SM_SPT);
    for (int i = gt; i < NLAYER * 2 * 512; i += NGT) SPT[i] = log1pf(__expf(-A.lru_lam[i]));
    v4u* WAF = (v4u*)(ws + WS_SMALL + SM_WAF);
    for (int i = gt; i < NLAYER * 2 * 4 * 4 * 2 * 64; i += NGT) { const int ln = i & 63, hl = (i >> 6) & 1, ct = (i >> 7) & 3, h = (i >> 9) & 3, dir = (i >> 11) & 1, l = i >> 12;
        const int c = 16 * ct + (ln & 15), qd = ln >> 4; float w[8];
#pragma unroll
        for (int j = 0; j < 8; ++j) w[j] = qd < 2 ? 1.4426950408889634f * A.gla_wa[(((size_t)l * 2 + dir) * 16 + 8 * qd + j) * 256 + h * 64 + c] : 0.f;
        v4u hw; hw.x = pk2(w[0], w[1]); hw.y = pk2(w[2], w[3]); hw.z = pk2(w[4], w[5]); hw.w = pk2(w[6], w[7]);
        if (hl) { hw = (v4u){pk2(w[0] - bflo(hw.x), w[1] - bfhi(hw.x)), pk2(w[2] - bflo(hw.y), w[3] - bfhi(hw.y)), pk2(w[4] - bflo(hw.z), w[5] - bfhi(hw.z)), pk2(w[6] - bflo(hw.w), w[7] - bfhi(hw.w))}; }
        WAF[i] = hw; }
}
DI void prologue_b(const Frame& F, const float* b_ada, const float* g_pre, const float* g_post) {
    const float* modp = (const float*)(F.ws + WS_MODP);
    float* premul = (float*)(F.ws + WS_VEC); float* preadd = premul + VEC_ELEMS; float* postmul = preadd + VEC_ELEMS;
    const int gt = F.bid * NTHR + F.tid, NGT = F.G * NTHR;
    for (int i = gt; i < (int)VEC_ELEMS; i += NGT) {
        const int d = i % D, s = (i / D) % NSEQ, lj = i / (D * NSEQ), l = lj / 3, j = lj % 3;
        float v[3];
#pragma unroll
        for (int t = 0; t < 3; ++t) { const int col = (j * 3 + t) * D + d; float a = b_ada[(size_t)l * NADA + col];
            for (int ks = 0; ks < MOD_KS; ++ks) a += modp[((size_t)(l * MOD_KS + ks) * NSEQ + s) * NADA + col];
            v[t] = a; }
        premul[i] = g_pre[lj * D + d] * (1.0f + v[1]); preadd[i] = v[0]; postmul[i] = (j == 1 ? 1.0f : 0.5f) * v[2] * g_post[lj * D + d];
    }
}
struct X16 { bf16* lo; bf16* hi; int split; };
DI bf16* x16_row(const X16& X, int m) { return m < X.split ? X.lo + (size_t)m * D : X.hi + (size_t)(m - X.split) * D; }
template <bool HAS_G, int XIN>
struct NormIn { v4u g[4]; v4u xb[4]; f32x4 xf[XIN == 0 ? 8 : 1]; };
template <bool HAS_G, int XIN>
DI void norm_load(NormIn<HAS_G, XIN>& I, int m, int lane, const float* xp, const float* xs, const X16& xi, const bf16* Gs) {
    if (XIN == 0) { const float* xr = m < SEQ ? xp + (size_t)m * D : xs + (size_t)(m - SEQ) * D;
#pragma unroll
        for (int j = 0; j < 4; ++j) { I.xf[2 * j] = *(const f32x4*)(xr + 8 * lane + 512 * j); I.xf[2 * j + 1] = *(const f32x4*)(xr + 8 * lane + 512 * j + 4); } }
    else { const bf16* xr = x16_row(xi, m);
#pragma unroll
        for (int j = 0; j < 4; ++j) I.xb[j] = *(const v4u*)(xr + 8 * lane + 512 * j); }
    if (HAS_G) {
#pragma unroll
        for (int j = 0; j < 4; ++j) I.g[j] = *(const v4u*)(Gs + (size_t)m * D + 8 * lane + 512 * j); }
}
template <bool HAS_G, int XIN, int XOUT, bool WRITE_H, bool lds_vec>
DI void norm_row(const Frame& F, const NormIn<HAS_G, XIN>& cu, int m, int s, const X16& xo, float* out, bf16* H, const float* postmul, const float* premul, const float* preadd, const float pscale) {
    LAS float* VPM = (LAS float*)F.lds; LAS float* VNM = VPM + D; LAS float* VNA = VNM + D;
    {
        f32x4 x[4][2];
#pragma unroll
        for (int j = 0; j < 4; ++j) {
            if (XIN == 0) { x[j][0] = cu.xf[XIN == 0 ? 2 * j : 0]; x[j][1] = cu.xf[XIN == 0 ? 2 * j + 1 : 0]; }
            else { const v4u w = cu.xb[j]; x[j][0] = (f32x4){bflo(w.x), bfhi(w.x), bflo(w.y), bfhi(w.y)}; x[j][1] = (f32x4){bflo(w.z), bfhi(w.z), bflo(w.w), bfhi(w.w)}; } }
        if (HAS_G) {
            f32x4 o[4][2]; float ss = 0.f;
#pragma unroll
            for (int j = 0; j < 4; ++j) { const v4u w = cu.g[j];
                o[j][0] = (f32x4){bflo(w.x), bfhi(w.x), bflo(w.y), bfhi(w.y)}; o[j][1] = (f32x4){bflo(w.z), bfhi(w.z), bflo(w.w), bfhi(w.w)};
#pragma unroll
                for (int h = 0; h < 2; ++h) ss += (o[j][h][0] * o[j][h][0] + o[j][h][1] * o[j][h][1]) + (o[j][h][2] * o[j][h][2] + o[j][h][3] * o[j][h][3]); }
            const float rinv = pscale * __builtin_amdgcn_rsqf(wave_sum(ss) * (1.0f / D) + EPS);
            const float* pm = postmul + (size_t)s * D;
#pragma unroll
            for (int j = 0; j < 4; ++j)
#pragma unroll
                for (int h = 0; h < 2; ++h) { const f32x4 p = lds_vec ? *(const LAS f32x4*)(VPM + 8 * F.lane + 512 * j + 4 * h) : *(const f32x4*)(pm + 8 * F.lane + 512 * j + 4 * h); x[j][h] += p * (o[j][h] * rinv); }
        }
        if (XOUT == 1) { bf16* xw = x16_row(xo, m);
#pragma unroll
            for (int j = 0; j < 4; ++j) { v4u w; w.x = pk2(x[j][0][0], x[j][0][1]); w.y = pk2(x[j][0][2], x[j][0][3]); w.z = pk2(x[j][1][0], x[j][1][1]); w.w = pk2(x[j][1][2], x[j][1][3]);
                *(v4u*)(xw + 8 * F.lane + 512 * j) = w; } }
        if (XOUT == 2) {
#pragma unroll
            for (int j = 0; j < 4; ++j) { *(f32x4*)(out + (size_t)m * D + 8 * F.lane + 512 * j) = x[j][0]; *(f32x4*)(out + (size_t)m * D + 8 * F.lane + 512 * j + 4) = x[j][1]; } }
        if (WRITE_H) {
            float ss = 0.f;
#pragma unroll
            for (int j = 0; j < 4; ++j)
#pragma unroll
                for (int h = 0; h < 2; ++h) ss += (x[j][h][0] * x[j][h][0] + x[j][h][1] * x[j][h][1]) + (x[j][h][2] * x[j][h][2] + x[j][h][3] * x[j][h][3]);
            const float rinv = __builtin_amdgcn_rsqf(wave_sum(ss) * (1.0f / D) + EPS);
            const float* pm = premul + (size_t)s * D; const float* pa = preadd + (size_t)s * D;
#pragma unroll
            for (int j = 0; j < 4; ++j) { f32x4 h0, h1;
                { const f32x4 a = lds_vec ? *(const LAS f32x4*)(VNM + 8 * F.lane + 512 * j) : *(const f32x4*)(pm + 8 * F.lane + 512 * j), b = lds_vec ? *(const LAS f32x4*)(VNA + 8 * F.lane + 512 * j) : *(const f32x4*)(pa + 8 * F.lane + 512 * j); h0 = x[j][0] * rinv * a + b; }
                { const f32x4 a = lds_vec ? *(const LAS f32x4*)(VNM + 8 * F.lane + 512 * j + 4) : *(const f32x4*)(pm + 8 * F.lane + 512 * j + 4), b = lds_vec ? *(const LAS f32x4*)(VNA + 8 * F.lane + 512 * j + 4) : *(const f32x4*)(pa + 8 * F.lane + 512 * j + 4); h1 = x[j][1] * rinv * a + b; }
                v4u w; w.x = pk2(h0[0], h0[1]); w.y = pk2(h0[2], h0[3]); w.z = pk2(h1[0], h1[1]); w.w = pk2(h1[2], h1[3]);
                *(v4u*)(H + (size_t)m * D + 8 * F.lane + 512 * j) = w; }
        }
    }
}
template <bool HAS_G, int XIN, int XOUT, bool WRITE_H, bool lds_vec>
DI void norm_rows_impl(const Frame& F, const float* xp, const float* xs, const X16 xi, const X16 xo, float* out, const bf16* Gs, bf16* H, const float* postmul, const float* premul, const float* preadd, const float pscale) {
    LAS float* VPM = (LAS float*)F.lds; LAS float* VNM = VPM + D; LAS float* VNA = VNM + D;
    int s_staged = -1;
    NormIn<HAS_G, XIN> ra, rb;
    if (F.gw < M) norm_load<HAS_G, XIN>(ra, F.gw, F.lane, xp, xs, xi, Gs);
#pragma unroll 1
    for (int m = F.gw; m < M; m += 2 * F.NGW) {
#pragma unroll
        for (int half = 0; half < 2; ++half) { const int mm = m + half * F.NGW; if (mm >= M) break;
            const int s = mm / SEQ;
            if (mm + F.NGW < M) { if (half == 0) norm_load<HAS_G, XIN>(rb, mm + F.NGW, F.lane, xp, xs, xi, Gs); else norm_load<HAS_G, XIN>(ra, mm + F.NGW, F.lane, xp, xs, xi, Gs); }
            if (lds_vec && s != s_staged) {
                LDS_BARRIER();
                for (int i = F.tid; i < D / 4; i += NTHR) { if (HAS_G) *(LAS f32x4*)(VPM + 4 * i) = *(const f32x4*)(postmul + (size_t)s * D + 4 * i);
                    if (WRITE_H) { *(LAS f32x4*)(VNM + 4 * i) = *(const f32x4*)(premul + (size_t)s * D + 4 * i); *(LAS f32x4*)(VNA + 4 * i) = *(const f32x4*)(preadd + (size_t)s * D + 4 * i); } }
                LDS_BARRIER(); s_staged = s; }
            if (half == 0) norm_row<HAS_G, XIN, XOUT, WRITE_H, lds_vec>(F, ra, mm, s, xo, out, H, postmul, premul, preadd, pscale);
            else norm_row<HAS_G, XIN, XOUT, WRITE_H, lds_vec>(F, rb, mm, s, xo, out, H, postmul, premul, preadd, pscale); }
    }
}
template <bool HAS_G, int XIN, int XOUT, bool WRITE_H>
DI void norm_rows(const Frame& F, const float* xp, const float* xs, const X16 xi, const X16 xo, float* out, const bf16* Gs, bf16* H, const float* postmul, const float* premul, const float* preadd, const float pscale = 1.0f) {
    if ((SEQ % F.NGW) == 0) norm_rows_impl<HAS_G, XIN, XOUT, WRITE_H, true>(F, xp, xs, xi, xo, out, Gs, H, postmul, premul, preadd, pscale);
    else norm_rows_impl<HAS_G, XIN, XOUT, WRITE_H, false>(F, xp, xs, xi, xo, out, Gs, H, postmul, premul, preadd, pscale);
}
DI void stage_matrix(const Frame& F, const bf16* src, int rows, int cols, int pitch_bytes) {
    const int per_row = cols / 8;
    for (int i = F.tid; i < rows * per_row; i += NTHR) { const int r = i / per_row, c = i % per_row;
        *(LAS v4u*)(F.lds + r * pitch_bytes + c * 16) = *(const v4u*)(src + (size_t)r * cols + c * 8); }
}
DI void fourier_a(const Frame& F) {
    const bf16* P = (const bf16*)(F.ws + WS_U); bf16* FT = (bf16*)(F.ws + WS_FT);
    sync_threads();
    stage_matrix(F, (const bf16*)(F.ws + WS_SMALL + SM_W1), 128, 128, 272);
    sync_threads();
    const int l15 = F.lane & 15, quad = F.lane >> 4;
    constexpr int NSL = NZ / 32;
    for (int task = F.gw; task < NSEQ * 128 * NSL; task += F.NGW) {
        const int cs = task % NSL, s2 = (task / NSL) & 127, seq = task / (NSL * 128);
        f32x4 acc[8][2];
#pragma unroll
        for (int a = 0; a < 8; ++a) { acc[a][0] = (f32x4){0.f, 0.f, 0.f, 0.f}; acc[a][1] = (f32x4){0.f, 0.f, 0.f, 0.f}; }
        const bf16* zb = P + (size_t)(seq * SEQ + s2) * NPC + P_ZR + cs * 32 + 2 * l15;
#pragma unroll 2
        for (int kk = 0; kk < 4; ++kk) {
            const int reim = kk >> 1, s1b = (kk & 1) * 32 + quad * 8;
            bf16x8 be, bo; unsigned w[8];
#pragma unroll
            for (int j = 0; j < 8; ++j) w[j] = *(const unsigned*)(zb + (size_t)(s1b + j) * 128 * NPC + reim * NZ);
            split8(w, be, bo);
#pragma unroll
            for (int mt = 0; mt < 8; ++mt) { const bf16x8 a = *(const LAS bf16x8*)(F.lds + (mt * 16 + l15) * 272 + (kk * 32 + quad * 8) * 2);
                acc[mt][0] = mfma16(a, be, acc[mt][0]); acc[mt][1] = mfma16(a, bo, acc[mt][1]); }
        }
#pragma unroll
        for (int mt = 0; mt < 4; ++mt)
#pragma unroll
            for (int r = 0; r < 4; ++r) { const int k1 = mt * 16 + quad * 4 + r; const float ph = (float)((s2 * k1) & 8191) * (1.0f / 8192.0f);
                const float c = __builtin_amdgcn_cosf(ph), s = __builtin_amdgcn_sinf(ph);
                bf16* o = FT + ((((size_t)seq * 64 + k1) * 128 + s2) * 2) * NZ + cs * 32 + 2 * l15;
                const float tr0 = acc[mt][0][r], ti0 = acc[mt + 4][0][r], tr1 = acc[mt][1][r], ti1 = acc[mt + 4][1][r];
                *(unsigned*)o = pk2(tr0 * c + ti0 * s, tr1 * c + ti1 * s);
                *(unsigned*)(o + NZ) = pk2(ti0 * c - tr0 * s, ti1 * c - tr1 * s); }
    }
}
DI void fourier_b(const Frame& F) {
    const bf16* FT = (const bf16*)(F.ws + WS_FT); bf16* Y = (bf16*)(F.ws + WS_H);
    sync_threads();
    stage_matrix(F, (const bf16*)(F.ws + WS_SMALL + SM_W2), 128, 256, 528);
    sync_threads();
    const int l15 = F.lane & 15, quad = F.lane >> 4;
    constexpr int NSL = NZ / 32;
    for (int task = F.gw; task < NSEQ * 64 * NSL; task += F.NGW) {
        const int cs = task % NSL, k1 = (task / NSL) & 63, seq = task / (NSL * 64);
        f32x4 acc[8][2];
#pragma unroll
        for (int a = 0; a < 8; ++a) { acc[a][0] = (f32x4){0.f, 0.f, 0.f, 0.f}; acc[a][1] = (f32x4){0.f, 0.f, 0.f, 0.f}; }
        const bf16* tb = FT + (((size_t)seq * 64 + k1) * 128) * 2 * NZ + cs * 32 + 2 * l15;
#pragma unroll 2
        for (int kk = 0; kk < 8; ++kk) {
            const int reim = kk >> 2, s2b = (kk & 3) * 32 + quad * 8;
            bf16x8 be, bo; unsigned w[8];
#pragma unroll
            for (int j = 0; j < 8; ++j) w[j] = *(const unsigned*)(tb + ((size_t)(s2b + j) * 2 + reim) * NZ);
            split8(w, be, bo);
#pragma unroll
            for (int mt = 0; mt < 8; ++mt) { const bf16x8 a = *(const LAS bf16x8*)(F.lds + (mt * 16 + l15) * 528 + (kk * 32 + quad * 8) * 2);
                acc[mt][0] = mfma16(a, be, acc[mt][0]); acc[mt][1] = mfma16(a, bo, acc[mt][1]); }
        }
        const int q = cs * 32 + 2 * l15, g = q >> 6, j = q & 63;
        bf16* yrow = Y + (size_t)seq * SEQ * D;
#pragma unroll
        for (int mt = 0; mt < 8; ++mt)
#pragma unroll
            for (int r = 0; r < 4; ++r) { const int k = k1 + 64 * (mt * 16 + quad * 4 + r), km = (SEQ - k) & (SEQ - 1); const float v0 = acc[mt][0][r], v1 = acc[mt][1][r];
                if (cs < 8) { *(unsigned*)(yrow + (size_t)k * D + g * 128 + j) = pk2(v0, v1);
                    bf16* ym = yrow + (size_t)km * D + g * 128 + 127 - j; ym[0] = f2bf(v1); if (j > 0) ym[1] = f2bf(v0); }
                else if (l15 < 2) { yrow[(size_t)k * D + (2 * l15) * 128 + 64] = f2bf(v0); yrow[(size_t)k * D + (2 * l15 + 1) * 128 + 64] = f2bf(v1); } }
    }
}

typedef short s16x4 __attribute__((ext_vector_type(4)));
DI v2u lds_tr16(LAS unsigned char* p) { const s16x4 v = __builtin_amdgcn_ds_read_tr16_b64_v4i16((LAS s16x4*)p); return __builtin_bit_cast(v2u, v); }
constexpr int G1W_REG = 16384;
DI int g1w_img(int c, int t, int u) { return c * 128 + (((t ^ ((c >> 1) & 3)) << 2) + u) * 8; }
DI int g1w_vimg(int row, int blk) { return row * 256 + ((blk ^ (row & 7)) << 5); }
DI float ls2(float zl) { return (fminf(zl, 0.f) - __builtin_amdgcn_logf(1.0f + __builtin_amdgcn_exp2f(-fabsf(zl)))) * (1.0f / 16.0f); }
template <int VAR = 0>
DI void gla_g1(const Frame& F, const v4u* w_alpha  , const float* b_alpha  ) {
    const bf16* P = (const bf16*)(F.ws + WS_U); bf16* OI = (bf16*)(F.ws + WS_OI); bf16* LS = (bf16*)(F.ws + WS_LS); bf16* QD = (bf16*)(F.ws + WS_QD); float* DD = (float*)(F.ws + WS_DD);
    constexpr int NITEM = NSEQ * 4 * 128 * 2;
    LDS_BARRIER();
#pragma unroll 1
    for (int item = F.NGW - 1 - F.gw; item < NITEM; item += F.NGW) {
    int lane_ = F.lane; asm volatile("" : "+v"(lane_));
    const int l15 = lane_ & 15, quad = lane_ >> 4, q4 = l15 >> 2, p4 = l15 & 3;
    LAS unsigned char* W = F.lds + F.wave * G1W_REG;
    bf16x8 sel[2];
#pragma unroll
    for (int e = 0; e < 2; ++e) { const bool on = quad == 2 * e + (l15 >> 3); const int jj = l15 & 7; const unsigned word = (jj & 1) ? 0x3F800000u : 0x00003F80u;
        v4u w; w.x = (on && (jj >> 1) == 0) ? word : 0u; w.y = (on && (jj >> 1) == 1) ? word : 0u; w.z = (on && (jj >> 1) == 2) ? word : 0u; w.w = (on && (jj >> 1) == 3) ? word : 0u; sel[e] = mk8(w); }
        const int dir = item & 1, cn = (item >> 1) & 127, h = (item >> 8) & 3, seq = item >> 10;
        const size_t m0 = (size_t)seq * SEQ + cn * 64;
        v4u al[4];
#pragma unroll
        for (int t = 0; t < 4; ++t) { const int tau = 16 * t + l15; const bf16* row = P + (m0 + (dir ? 63 - tau : tau)) * NPC;
            const v4u a = *(const v4u*)(row + P_AL + dir * 16 + 8 * (quad & 1)); al[t] = quad < 2 ? a : (v4u){0u, 0u, 0u, 0u}; }
        f32x4 z[4][4];
        {   bf16x8 wh[4], wl[4]; float ba[4];
            const v4u* wf = w_alpha + (size_t)((dir * 4 + h) * 4) * 2 * 64 + lane_;
#pragma unroll
            for (int ct = 0; ct < 4; ++ct) { wh[ct] = mk8(wf[(ct * 2) * 64]); wl[ct] = mk8(wf[(ct * 2 + 1) * 64]); ba[ct] = 1.4426950408889634f * b_alpha[dir * 256 + h * 64 + 16 * ct + l15]; }
#pragma unroll
            for (int t = 0; t < 4; ++t)
#pragma unroll
                for (int ct = 0; ct < 4; ++ct) { f32x4 a = (f32x4){ba[ct], ba[ct], ba[ct], ba[ct]}; a = mfma16(mk8(al[t]), wh[ct], a); z[t][ct] = mfma16(mk8(al[t]), wl[ct], a); } }
        __builtin_amdgcn_sched_barrier(0);
        v4u qa[4][2], ka[4][2];
#pragma unroll
        for (int t = 0; t < 4; ++t) { const int tau = 16 * t + l15; const bf16* row = P + (m0 + (dir ? 63 - tau : tau)) * NPC;
#pragma unroll
            for (int kk = 0; kk < 2; ++kk) { qa[t][kk] = *(const v4u*)(row + P_Q + h * 64 + 32 * kk + 8 * quad); ka[t][kk] = *(const v4u*)(row + P_K + h * 64 + 32 * kk + 8 * quad); } }
        __builtin_amdgcn_sched_barrier(0);
        float run[4] = {0.f, 0.f, 0.f, 0.f};
#pragma unroll
        for (int t = 0; t < 4; ++t)
#pragma unroll
            for (int ct = 0; ct < 4; ++ct) { const f32x4 zz = z[t][ct];
                const float p0 = ls2(zz[0]), p1 = p0 + ls2(zz[1]), p2 = p1 + ls2(zz[2]), p3 = p2 + ls2(zz[3]);
                const float s0 = shfl_f(p3, l15), s1 = shfl_f(p3, l15 + 16), s2 = shfl_f(p3, l15 + 32), s3 = shfl_f(p3, l15 + 48);
                const float base = run[ct] + ((quad > 0 ? s0 : 0.f) + (quad > 1 ? s1 : 0.f) + (quad > 2 ? s2 : 0.f));
                z[t][ct] = (f32x4){base + p0, base + p1, base + p2, base + p3}; run[ct] += (s0 + s1) + (s2 + s3); }
        float dtot[4];
#pragma unroll
        for (int ct = 0; ct < 4; ++ct) dtot[ct] = __builtin_amdgcn_exp2f(run[ct]);
        if (quad == 0) {
#pragma unroll
            for (int ct = 0; ct < 4; ++ct) DD[(size_t)item * 64 + 16 * ct + l15] = dtot[ct]; }
        v2u ktr[4][4];
#pragma unroll
        for (int t = 0; t < 4; ++t)
#pragma unroll
            for (int ct = 0; ct < 4; ++ct) { const f32x4 zero = (f32x4){0.f, 0.f, 0.f, 0.f};
                const f32x4 qc = mfma16(mk8(qa[t][ct >> 1]), sel[ct & 1], zero), kc = mfma16(mk8(ka[t][ct >> 1]), sel[ct & 1], zero);
                float qt[4], kt[4];
#pragma unroll
                for (int r = 0; r < 4; ++r) { const float e1 = __builtin_amdgcn_exp2f(z[t][ct][r] - run[ct]), e2 = __builtin_amdgcn_rcpf(e1); qt[r] = qc[r] * 0.125f * e1; kt[r] = kc[r] * e2; }
                const v2u qp = (v2u){pk2(qt[0], qt[1]), pk2(qt[2], qt[3])}, kp = (v2u){pk2(kt[0], kt[1]), pk2(kt[2], kt[3])};
                ktr[t][ct] = kp; const int off = g1w_img(16 * ct + l15, t, quad);
                *(LAS v2u*)(W + off) = kp; *(LAS v2u*)(W + 8192 + off) = qp; }
        __builtin_amdgcn_sched_barrier(0);
        v4u vv[16];
#pragma unroll
        for (int i = 0; i < 16; ++i) { const int tau = 4 * i + quad; vv[i] = *(const v4u*)(P + (m0 + (dir ? 63 - tau : tau)) * NPC + P_V + h * 128 + 8 * l15); }
        asm volatile("" ::: "memory");
        bf16x8 pf[4][2];
        {   bf16x8 kf[4][2];
#pragma unroll
            for (int si = 0; si < 4; ++si)
#pragma unroll
                for (int kk = 0; kk < 2; ++kk) kf[si][kk] = mk8(lds_tr16(W + g1w_img(32 * kk + 4 * quad + q4, si, p4)), lds_tr16(W + g1w_img(32 * kk + 16 + 4 * quad + q4, si, p4)));
#pragma unroll
            for (int ti = 0; ti < 4; ++ti) { bf16x8 qf[2]; f32x4 sc[4];
#pragma unroll
                for (int kk = 0; kk < 2; ++kk) { qf[kk] = mk8(lds_tr16(W + 8192 + g1w_img(32 * kk + 4 * quad + q4, ti, p4)), lds_tr16(W + 8192 + g1w_img(32 * kk + 16 + 4 * quad + q4, ti, p4)));
                    *(v4u*)(QD + ((((size_t)item * 4 + ti) * 2 + kk) * 64 + lane_) * 8) = __builtin_bit_cast(v4u, qf[kk]); }
#pragma unroll
                for (int si = 0; si < 4; ++si) { sc[si] = (f32x4){0.f, 0.f, 0.f, 0.f};
                    if (si <= ti) { sc[si] = mfma16(kf[si][0], qf[0], sc[si]); sc[si] = mfma16(kf[si][1], qf[1], sc[si]);
                        if (si == ti) {
#pragma unroll
                            for (int r = 0; r < 4; ++r) if (quad * 4 + r > l15) sc[si][r] = 0.f; } } }
#pragma unroll
                for (int k2 = 0; k2 < 2; ++k2) { v4u w; w.x = pk2(sc[2 * k2][0], sc[2 * k2][1]); w.y = pk2(sc[2 * k2][2], sc[2 * k2][3]); w.z = pk2(sc[2 * k2 + 1][0], sc[2 * k2 + 1][1]); w.w = pk2(sc[2 * k2 + 1][2], sc[2 * k2 + 1][3]); pf[ti][k2] = mk8(w); } } }
        asm volatile("" ::: "memory");
        __builtin_amdgcn_sched_barrier(0);
#pragma unroll
        for (int i = 0; i < 16; ++i) { const int tau = 4 * i + quad; *(LAS v4u*)(W + g1w_vimg(tau, l15 >> 1) + 16 * (l15 & 1)) = vv[i]; }
        asm volatile("" ::: "memory");
#pragma unroll
        for (int dt = 0; dt < 8; ++dt) { bf16x8 vt[2];
#pragma unroll
            for (int k2 = 0; k2 < 2; ++k2) { const int r0 = 32 * k2 + 4 * quad + q4; vt[k2] = mk8(lds_tr16(W + g1w_vimg(r0, dt) + 8 * p4), lds_tr16(W + g1w_vimg(r0 + 16, dt) + 8 * p4)); }
#pragma unroll
            for (int ti = 0; ti < 4; ++ti) { f32x4 acc = (f32x4){0.f, 0.f, 0.f, 0.f}; acc = mfma16(vt[0], pf[ti][0], acc); if (ti >= 2) acc = mfma16(vt[1], pf[ti][1], acc);
                *(v2u*)(OI + (((size_t)item * 4 + ti) * 8 + dt) * 256 + lane_ * 4) = (v2u){pk2(acc[0], acc[1]), pk2(acc[2], acc[3])}; }
#pragma unroll
            for (int ct = 0; ct < 4; ++ct) { f32x4 acc = (f32x4){0.f, 0.f, 0.f, 0.f};
#pragma unroll
                for (int k2 = 0; k2 < 2; ++k2) acc = mfma16(mk8(ktr[2 * k2][ct], ktr[2 * k2 + 1][ct]), vt[k2], acc);
                *(v2u*)(LS + (size_t)item * 8192 + ((dt * 4 + ct) * 64 + lane_) * 4) = (v2u){pk2(acc[0], acc[1]), pk2(acc[2], acc[3])}; } }
        asm volatile("" ::: "memory");
    }
}
DI void gla_g2(const Frame& F) {
    bf16* LS = (bf16*)(F.ws + WS_LS); const float* DD = (const float*)(F.ws + WS_DD);
    for (int it = F.NGW - 1 - F.gw; it < NSEQ * 4 * 2 * 32; it += F.NGW) {
        const int blk = it & 31, chain = it >> 5, dir = chain & 1, sh = chain >> 1;
        const int e = blk * 256 + F.lane * 4, cc = (blk & 3) * 16 + (F.lane >> 4) * 4;
        f32x4 S = (f32x4){0.f, 0.f, 0.f, 0.f};
#pragma unroll 1
        for (int sb = 0; sb < 128; sb += 8) {
            v2u w[8]; f32x4 dv[8];
#pragma unroll
            for (int u = 0; u < 8; ++u) { const int st = sb + u, cn = dir ? 127 - st : st; const size_t item = ((size_t)sh * 128 + cn) * 2 + dir;
                w[u] = *(const v2u*)(LS + item * 8192 + e); dv[u] = *(const f32x4*)(DD + item * 64 + cc); }
#pragma unroll
            for (int u = 0; u < 8; ++u) { const int st = sb + u, cn = dir ? 127 - st : st; const size_t item = ((size_t)sh * 128 + cn) * 2 + dir;
                const f32x4 dS = dv[u] * S;
                *(v2u*)(LS + item * 8192 + e) = (v2u){pk2(dS[0], dS[1]), pk2(dS[2], dS[3])};
                S = dS + (f32x4){bflo(w[u].x), bfhi(w[u].x), bflo(w[u].y), bfhi(w[u].y)}; }
        }
    }
}
DI void gla_g3(const Frame& F, const float* norm_g  ) {
    const bf16* P = (const bf16*)(F.ws + WS_U); const bf16* OI = (const bf16*)(F.ws + WS_OI); const bf16* LS = (const bf16*)(F.ws + WS_LS); const bf16* QD = (const bf16*)(F.ws + WS_QD); bf16* Y = (bf16*)(F.ws + WS_H);
#pragma unroll 1
    for (int task = F.NGW - 1 - F.gw; task < NSEQ * 4 * 128 * 2; task += F.NGW) {
        int lane_ = F.lane; asm volatile("" : "+v"(lane_));
        const int l15 = lane_ & 15, quad = lane_ >> 4;
        const int tp = task & 1, cn = (task >> 1) & 127, h = (task >> 8) & 3, seq = task >> 10;
        const size_t item0 = ((size_t)(seq * 4 + h) * 128 + cn) * 2;
        f32x4 acc[2][8];
        {   v2u oa[2][8], ob[2][8];
#pragma unroll
            for (int u = 0; u < 2; ++u) { const int ti = 2 * tp + u;
#pragma unroll
                for (int dt = 0; dt < 8; ++dt) { oa[u][dt] = *(const v2u*)(OI + ((item0 * 4 + ti) * 8 + dt) * 256 + lane_ * 4); ob[u][dt] = *(const v2u*)(OI + (((item0 + 1) * 4 + (3 - ti)) * 8 + dt) * 256 + (quad * 16 + 15 - l15) * 4); } }
#pragma unroll
            for (int u = 0; u < 2; ++u)
#pragma unroll
                for (int dt = 0; dt < 8; ++dt) acc[u][dt] = (f32x4){bflo(oa[u][dt].x) + bflo(ob[u][dt].x), bfhi(oa[u][dt].x) + bfhi(ob[u][dt].x), bflo(oa[u][dt].y) + bflo(ob[u][dt].y), bfhi(oa[u][dt].y) + bfhi(ob[u][dt].y)}; }
#pragma unroll
        for (int dir = 0; dir < 2; ++dir) { const bf16* ls = LS + (item0 + dir) * 8192 + lane_ * 4;
            v2u sf[8][2][2]; bf16x8 bq[2][2];
#pragma unroll
            for (int dt = 0; dt < 8; ++dt)
#pragma unroll
                for (int kk = 0; kk < 2; ++kk) { sf[dt][kk][0] = *(const v2u*)(ls + (dt * 4 + 2 * kk) * 256); sf[dt][kk][1] = *(const v2u*)(ls + (dt * 4 + 2 * kk + 1) * 256); }
#pragma unroll
            for (int u = 0; u < 2; ++u) { const int ti = 2 * tp + u; const bf16* qd = QD + (((item0 + dir) * 4 + (dir ? 3 - ti : ti)) * 2 * 64 + (dir ? quad * 16 + 15 - l15 : lane_)) * 8;
#pragma unroll
                for (int kk = 0; kk < 2; ++kk) bq[u][kk] = mk8(*(const v4u*)(qd + kk * 512)); }
            __builtin_amdgcn_sched_barrier(0);
#pragma unroll
            for (int kk = 0; kk < 2; ++kk)
#pragma unroll
                for (int dt = 0; dt < 8; ++dt) { const bf16x8 s = mk8(sf[dt][kk][0], sf[dt][kk][1]); acc[0][dt] = mfma16(s, bq[0][kk], acc[0][dt]); acc[1][dt] = mfma16(s, bq[1][kk], acc[1][dt]); }
            __builtin_amdgcn_sched_barrier(0); }
#pragma unroll
        for (int u = 0; u < 2; ++u) { const int ti = 2 * tp + u; const size_t m = (size_t)seq * SEQ + cn * 64 + ti * 16 + l15;
            v2u og[8];
#pragma unroll
            for (int dt = 0; dt < 8; ++dt) og[dt] = *(const v2u*)(P + m * NPC + P_OG + h * 128 + dt * 16 + quad * 4);
            float ss = 0.f;
#pragma unroll
            for (int dt = 0; dt < 8; ++dt) ss += (acc[u][dt][0] * acc[u][dt][0] + acc[u][dt][1] * acc[u][dt][1]) + (acc[u][dt][2] * acc[u][dt][2] + acc[u][dt][3] * acc[u][dt][3]);
            ss += shfl_xor_f(ss, 16); ss += shfl_xor_f(ss, 32);
            const float rinv = __builtin_amdgcn_rsqf(ss * (1.0f / 128.0f) + EPS);
#pragma unroll
            for (int dt = 0; dt < 8; ++dt) { const v2u g = og[dt]; const f32x4 ng = *(const f32x4*)(norm_g + dt * 16 + quad * 4);
                const float y0 = acc[u][dt][0] * rinv * ng[0] * bflo(g.x), y1 = acc[u][dt][1] * rinv * ng[1] * bfhi(g.x), y2 = acc[u][dt][2] * rinv * ng[2] * bflo(g.y), y3 = acc[u][dt][3] * rinv * ng[3] * bfhi(g.y);
                *(v2u*)(Y + m * D + 512 + h * 128 + dt * 16 + quad * 4) = (v2u){pk2(y0, y1), pk2(y2, y3)}; } }
    }
}

constexpr int LR_CW = 0, LR_CB = 16384, LR_WW = 20480, LR_WSTRIDE = 10496, LR_T = 8192;
constexpr int LRU_NCH = SEQ / 64;
constexpr size_t LRU_AU_OFF = (size_t)M * D / 2;
constexpr size_t LCAR_OFF = (size_t)NSEQ * 2 * LRU_NCH * 2 * 512;
struct LruArgs { const float *conv_w, *conv_b, *b_a, *b_x; };
template <bool PASS2, int VAR = 0>
DI void lru_pass(const Frame& F, const LruArgs& A, int layer) {
    const bf16* P = (const bf16*)(F.ws + WS_U); bf16* Y = (bf16*)(F.ws + WS_H); float* LSUM = (float*)(F.ws + WS_LSUM); unsigned* AU = (unsigned*)(F.out + LRU_AU_OFF);
    const bf16* WAT = (const bf16*)(F.ws + WS_SMALL + SM_WAT); const bf16* WXT = (const bf16*)(F.ws + WS_SMALL + SM_WXT); const float* SPT = (const float*)(F.ws + WS_SMALL + SM_SPT) + layer * 1024;
    LAS float* CW = (LAS float*)(F.lds + LR_CW); LAS float* CB = (LAS float*)(F.lds + LR_CB);
    sync_threads();
    for (int i = F.tid; i < 2 * 4 * 512; i += NTHR) CW[i] = A.conv_w[i];
    for (int i = F.tid; i < 2 * 512; i += NTHR) CB[i] = A.conv_b[i];
    sync_threads();
    const int l15 = F.lane & 15, quad = F.lane >> 4;
    bf16x8 idf[2];
#pragma unroll
    for (int e = 0; e < 2; ++e) { const int ee = e * 16 + l15 - quad * 8; v4u idw;
        idw.x = (ee == 0 ? 0x3f80u : 0u) | (ee == 1 ? 0x3f800000u : 0u); idw.y = (ee == 2 ? 0x3f80u : 0u) | (ee == 3 ? 0x3f800000u : 0u);
        idw.z = (ee == 4 ? 0x3f80u : 0u) | (ee == 5 ? 0x3f800000u : 0u); idw.w = (ee == 6 ? 0x3f80u : 0u) | (ee == 7 ? 0x3f800000u : 0u); idf[e] = mk8(idw); }
    for (int task = F.gw; task < NSEQ * LRU_NCH * 8; task += F.NGW) {
        const int blk = task & 7, cq = (task >> 3) & (LRU_NCH - 1), seq = task >> 10;
        const int t0 = cq * 64; const size_t mrow0 = (size_t)seq * SEQ;
#pragma unroll 1
        for (int dir = 0; dir < 2; ++dir) {
            const size_t wb = ((size_t)(layer * 2 + dir) * 8 + blk) * 4096;
            LAS unsigned char* ww = F.lds + LR_WW + F.wave * LR_WSTRIDE;
#pragma unroll
            for (int i = 0; i < 8; ++i) { const int ci = i * 64 + F.lane, row = ci >> 3, ch = ci & 7;
                *(LAS v4u*)(ww + row * 128 + ((ch ^ (row & 7)) << 4)) = *(const v4u*)(WXT + wb + ci * 8); }
            bf16x8 wa[4][2];
#pragma unroll
            for (int jt = 0; jt < 4; ++jt)
#pragma unroll
                for (int kk = 0; kk < 2; ++kk) wa[jt][kk] = *(const bf16x8*)(WAT + wb + (jt * 16 + l15) * 64 + kk * 32 + quad * 8);
            float ba[4], bx[4], sp[4];
#pragma unroll
            for (int jt = 0; jt < 4; ++jt) { const int ch = dir * 512 + blk * 64 + jt * 16 + l15; ba[jt] = -1.4426950408889634f * A.b_a[ch]; bx[jt] = -1.4426950408889634f * A.b_x[ch]; sp[jt] = -8.0f * 1.4426950408889634f * SPT[ch]; }
            float carry[4], atot[4];
#pragma unroll
            for (int jt = 0; jt < 4; ++jt) { carry[jt] = 0.f; atot[jt] = 1.f; }
            if (PASS2) {
                const float* cp = LSUM + LCAR_OFF + ((size_t)((seq * 2 + dir) * LRU_NCH + cq)) * 512 + blk * 64 + l15;
#pragma unroll
                for (int jt = 0; jt < 4; ++jt) carry[jt] = cp[jt * 16];
            }
            v4u xr[2][4], xn[2][4];
            const int lrow = dir ? 15 - l15 : l15;
            { const int tt0 = dir ? 3 : 0, tq = t0 + tt0 * 16 + lrow;
#pragma unroll
              for (int kk = 0; kk < 2; ++kk)
#pragma unroll
                  for (int k = 0; k < 4; ++k) { const int tr = dir ? tq + 3 - k : tq - 3 + k; const bool in = tr >= 0 && tr < SEQ;
                      const v4u v = *(const v4u*)(P + (mrow0 + (in ? tr : 0)) * NPC + P_RI + blk * 64 + kk * 32 + quad * 8); xr[kk][k] = v; } }
#pragma unroll
            for (int ts = 0; ts < 4; ++ts) {
                const int tt = dir ? 3 - ts : ts, tb = t0 + tt * 16, t = tb + lrow;
                if (ts < 3) { const int tqn = t0 + (dir ? 2 - ts : ts + 1) * 16 + lrow;
#pragma unroll
                    for (int kk = 0; kk < 2; ++kk)
#pragma unroll
                        for (int k = 0; k < 4; ++k) { const int tr = dir ? tqn + 3 - k : tqn - 3 + k; const bool in = tr >= 0 && tr < SEQ;
                            const v4u v = *(const v4u*)(P + (mrow0 + (in ? tr : 0)) * NPC + P_RI + blk * 64 + kk * 32 + quad * 8); xn[kk][k] = v; } }
                bf16x8 af[2];
#pragma unroll
                for (int kk = 0; kk < 2; ++kk) { const int chb = blk * 64 + kk * 32 + quad * 8;
                    f32x4 x0 = *(const LAS f32x4*)(CB + dir * 512 + chb), x1 = *(const LAS f32x4*)(CB + dir * 512 + chb + 4);
#pragma unroll
                    for (int k = 0; k < 4; ++k) { const int tr = dir ? t + 3 - k : t - 3 + k; const unsigned mk = (tr >= 0 && tr < SEQ) ? 0xffffffffu : 0u;
                        const v4u w = xr[kk][k] & (v4u){mk, mk, mk, mk};
                        const f32x4 w0 = *(const LAS f32x4*)(CW + (dir * 4 + k) * 512 + chb), w1 = *(const LAS f32x4*)(CW + (dir * 4 + k) * 512 + chb + 4);
                        x0 += w0 * (f32x4){bflo(w.x), bfhi(w.x), bflo(w.y), bfhi(w.y)}; x1 += w1 * (f32x4){bflo(w.z), bfhi(w.z), bflo(w.w), bfhi(w.w)}; }
                    af[kk] = mk8((v4u){pk2(x0[0], x0[1]), pk2(x0[2], x0[3]), pk2(x1[0], x1[1]), pk2(x1[2], x1[3])}); }
#pragma unroll
                for (int jt = 0; jt < 4; ++jt) {
                    f32x4 ga = (f32x4){0.f, 0.f, 0.f, 0.f}, gx = (f32x4){0.f, 0.f, 0.f, 0.f};
#pragma unroll
                    for (int kk = 0; kk < 2; ++kk) { const int row = jt * 16 + l15, off = row * 128 + (((kk * 4 + quad) ^ (row & 7)) << 4);
                        ga = mfma16(af[kk], wa[jt][kk], ga); gx = mfma16(af[kk], *(const LAS bf16x8*)(ww + off), gx); }
                    const f32x4 xi = mfma16(af[jt >> 1], idf[jt & 1], (f32x4){0.f, 0.f, 0.f, 0.f});
                    float av[4], uv[4], lav[4];
#pragma unroll
                    for (int r = 0; r < 4; ++r) { const float rg = VAR == 3 ? ga[r] + ba[jt] : __builtin_amdgcn_rcpf(1.0f + __builtin_amdgcn_exp2f(ga[r] + ba[jt])), ig = VAR == 3 ? gx[r] + bx[jt] : __builtin_amdgcn_rcpf(1.0f + __builtin_amdgcn_exp2f(gx[r] + bx[jt])); const float la = rg * sp[jt];
                        lav[r] = la; av[r] = VAR == 3 ? la : __builtin_amdgcn_exp2f(la); uv[r] = __builtin_amdgcn_sqrtf(fmaxf(1.0f - av[r] * av[r], 0.f)) * (ig * xi[r]); }
                    if (!PASS2 && (VAR != 1 || lav[0] == 1.2345f)) __builtin_nontemporal_store((v4u){pk2(lav[0], lav[1]), pk2(lav[2], lav[3]), pk2(uv[0], uv[1]), pk2(uv[2], uv[3])}, (v4u*)(AU + ((((size_t)(task * 2 + dir) * 4 + tt) * 4 + jt) * 64 + F.lane) * 4));
                    float pp[4], hh[4]; float pa = 1.f, hl = 0.f;
#pragma unroll
                    for (int r = 0; r < 4; ++r) { hl = av[r] * hl + uv[r]; pa *= av[r]; pp[r] = pa; hh[r] = hl; }
                    float cin = carry[jt], tout = carry[jt], ptile = 1.f;
#pragma unroll
                    for (int q = 0; q < 4; ++q) { const float qa = VAR == 2 ? pa : shfl_f(pa, l15 + 16 * q), qh = VAR == 2 ? hl : shfl_f(hl, l15 + 16 * q);
                        if (q < quad) cin = qa * cin + qh; tout = qa * tout + qh; ptile *= qa; }
                    carry[jt] = tout; atot[jt] *= ptile;
                    if (jt == 1) __builtin_amdgcn_sched_barrier(0);
                    if (PASS2) {
                        float hf[4];
#pragma unroll
                        for (int r = 0; r < 4; ++r) hf[r] = hh[r] + pp[r] * cin;
#pragma unroll
                        for (int r = 0; r < 4; ++r) *(LAS bf16*)(ww + LR_T + (quad * 4 + r) * 144 + (jt * 16 + l15) * 2) = f2bf(hf[r]);
                    }
                }
                if (PASS2) {
                    const int tok = F.lane >> 2, part = F.lane & 3; bf16* yp = Y + (mrow0 + tb + tok) * D + 1024 + blk * 64 + part * 16;
                    const v4u t0v = *(const LAS v4u*)(ww + LR_T + tok * 144 + part * 32), t1v = *(const LAS v4u*)(ww + LR_T + tok * 144 + part * 32 + 16);
                    if (dir == 0) { *(v4u*)yp = t0v; *(v4u*)(yp + 8) = t1v; }
                    else { const bf16* gp = P + (mrow0 + tb + tok) * NPC + P_RG + blk * 64 + part * 16;
                        const v4u f0 = *(const v4u*)yp, f1 = *(const v4u*)(yp + 8), g0 = *(const v4u*)gp, g1 = *(const v4u*)(gp + 8);
                        v4u o0, o1;
                        o0.x = pk2((bflo(f0.x) + bflo(t0v.x)) * bflo(g0.x), (bfhi(f0.x) + bfhi(t0v.x)) * bfhi(g0.x)); o0.y = pk2((bflo(f0.y) + bflo(t0v.y)) * bflo(g0.y), (bfhi(f0.y) + bfhi(t0v.y)) * bfhi(g0.y));
                        o0.z = pk2((bflo(f0.z) + bflo(t0v.z)) * bflo(g0.z), (bfhi(f0.z) + bfhi(t0v.z)) * bfhi(g0.z)); o0.w = pk2((bflo(f0.w) + bflo(t0v.w)) * bflo(g0.w), (bfhi(f0.w) + bfhi(t0v.w)) * bfhi(g0.w));
                        o1.x = pk2((bflo(f1.x) + bflo(t1v.x)) * bflo(g1.x), (bfhi(f1.x) + bfhi(t1v.x)) * bfhi(g1.x)); o1.y = pk2((bflo(f1.y) + bflo(t1v.y)) * bflo(g1.y), (bfhi(f1.y) + bfhi(t1v.y)) * bfhi(g1.y));
                        o1.z = pk2((bflo(f1.z) + bflo(t1v.z)) * bflo(g1.z), (bfhi(f1.z) + bfhi(t1v.z)) * bfhi(g1.z)); o1.w = pk2((bflo(f1.w) + bflo(t1v.w)) * bflo(g1.w), (bfhi(f1.w) + bfhi(t1v.w)) * bfhi(g1.w));
                        *(v4u*)yp = o0; *(v4u*)(yp + 8) = o1; }
                }
#pragma unroll
                for (int kk = 0; kk < 2; ++kk)
#pragma unroll
                    for (int k = 0; k < 4; ++k) xr[kk][k] = xn[kk][k];
            }
            if (!PASS2 && quad == 0 && (VAR == 0 || VAR == 1 || carry[0] == 1.2345f)) { float* s = LSUM + ((size_t)((seq * 2 + dir) * LRU_NCH + cq) * 2) * 512 + blk * 64 + l15;
#pragma unroll
                for (int jt = 0; jt < 4; ++jt) { s[jt * 16] = atot[jt]; s[512 + jt * 16] = carry[jt]; } }
        }
    }
}

DI void lru_out(const Frame& F) {
    const bf16* P = (const bf16*)(F.ws + WS_U); bf16* Y = (bf16*)(F.ws + WS_H); const float* LSUM = (const float*)(F.ws + WS_LSUM); const unsigned* AU = (const unsigned*)(F.out + LRU_AU_OFF);
    const int l15 = F.lane & 15, quad = F.lane >> 4;
    LAS unsigned char* tt_lds = F.lds + F.wave * 4096;
    for (int task = F.gw; task < NSEQ * LRU_NCH * 8; task += F.NGW) {
        const int blk = task & 7, cq = (task >> 3) & (LRU_NCH - 1), seq = task >> 10;
        const int t0 = cq * 64; const size_t mrow0 = (size_t)seq * SEQ;
        v4u hf[4][2];
#pragma unroll
        for (int dir = 0; dir < 2; ++dir) {
            float carry[4];
            { const float* cp = LSUM + LCAR_OFF + ((size_t)((seq * 2 + dir) * LRU_NCH + cq)) * 512 + blk * 64 + l15;
#pragma unroll
              for (int jt = 0; jt < 4; ++jt) carry[jt] = cp[jt * 16]; }
            v4u cur[4], nxt[4];
            { const int tt0 = dir ? 3 : 0;
#pragma unroll
              for (int jt = 0; jt < 4; ++jt) cur[jt] = *(const v4u*)(AU + ((((size_t)(task * 2 + dir) * 4 + tt0) * 4 + jt) * 64 + F.lane) * 4); }
#pragma unroll
            for (int ts = 0; ts < 4; ++ts) {
                const int tt = dir ? 3 - ts : ts, tb = t0 + tt * 16;
                const int tok = F.lane >> 2, part = F.lane & 3; bf16* yp = Y + (mrow0 + tb + tok) * D + 1024 + blk * 64 + part * 16;
                v4u f0 = (v4u){0u, 0u, 0u, 0u}, f1 = f0, g0 = f0, g1 = f0;
                if (dir == 1) { const bf16* gp = P + (mrow0 + tb + tok) * NPC + P_RG + blk * 64 + part * 16; f0 = hf[tt][0]; f1 = hf[tt][1]; g0 = *(const v4u*)gp; g1 = *(const v4u*)(gp + 8); }
                if (ts < 3) { const int ttn = dir ? 2 - ts : ts + 1;
#pragma unroll
                    for (int jt = 0; jt < 4; ++jt) nxt[jt] = *(const v4u*)(AU + ((((size_t)(task * 2 + dir) * 4 + ttn) * 4 + jt) * 64 + F.lane) * 4); }
#pragma unroll
                for (int jt = 0; jt < 4; ++jt) {
                    const v4u w = cur[jt];
                    float av[4], uv[4];
                    av[0] = __builtin_amdgcn_exp2f(bflo(w.x)); av[1] = __builtin_amdgcn_exp2f(bfhi(w.x)); av[2] = __builtin_amdgcn_exp2f(bflo(w.y)); av[3] = __builtin_amdgcn_exp2f(bfhi(w.y));
                    uv[0] = bflo(w.z); uv[1] = bfhi(w.z); uv[2] = bflo(w.w); uv[3] = bfhi(w.w);
                    float pp[4], hh[4]; float pa = 1.f, hl = 0.f;
#pragma unroll
                    for (int r = 0; r < 4; ++r) { hl = av[r] * hl + uv[r]; pa *= av[r]; pp[r] = pa; hh[r] = hl; }
                    float cin = carry[jt], tout = carry[jt];
#pragma unroll
                    for (int q = 0; q < 4; ++q) { const float qa = shfl_f(pa, l15 + 16 * q), qh = shfl_f(hl, l15 + 16 * q);
                        if (q < quad) cin = qa * cin + qh; tout = qa * tout + qh; }
                    carry[jt] = tout;
#pragma unroll
                    for (int r = 0; r < 4; ++r) *(LAS bf16*)(tt_lds + (dir ? 15 - (quad * 4 + r) : quad * 4 + r) * 144 + (jt * 16 + l15) * 2) = f2bf(hh[r] + pp[r] * cin);
                }
                const v4u t0v = *(const LAS v4u*)(tt_lds + tok * 144 + part * 32), t1v = *(const LAS v4u*)(tt_lds + tok * 144 + part * 32 + 16);
                if (dir == 0) { hf[tt][0] = t0v; hf[tt][1] = t1v; }
                else { v4u o0, o1;
                    o0.x = pk2((bflo(f0.x) + bflo(t0v.x)) * bflo(g0.x), (bfhi(f0.x) + bfhi(t0v.x)) * bfhi(g0.x)); o0.y = pk2((bflo(f0.y) + bflo(t0v.y)) * bflo(g0.y), (bfhi(f0.y) + bfhi(t0v.y)) * bfhi(g0.y));
                    o0.z = pk2((bflo(f0.z) + bflo(t0v.z)) * bflo(g0.z), (bfhi(f0.z) + bfhi(t0v.z)) * bfhi(g0.z)); o0.w = pk2((bflo(f0.w) + bflo(t0v.w)) * bflo(g0.w), (bfhi(f0.w) + bfhi(t0v.w)) * bfhi(g0.w));
                    o1.x = pk2((bflo(f1.x) + bflo(t1v.x)) * bflo(g1.x), (bfhi(f1.x) + bfhi(t1v.x)) * bfhi(g1.x)); o1.y = pk2((bflo(f1.y) + bflo(t1v.y)) * bflo(g1.y), (bfhi(f1.y) + bfhi(t1v.y)) * bfhi(g1.y));
                    o1.z = pk2((bflo(f1.z) + bflo(t1v.z)) * bflo(g1.z), (bfhi(f1.z) + bfhi(t1v.z)) * bfhi(g1.z)); o1.w = pk2((bflo(f1.w) + bflo(t1v.w)) * bflo(g1.w), (bfhi(f1.w) + bfhi(t1v.w)) * bfhi(g1.w));
                    *(v4u*)yp = o0; *(v4u*)(yp + 8) = o1; }
#pragma unroll
                for (int jt = 0; jt < 4; ++jt) cur[jt] = nxt[jt];
            }
        }
    }
}

DI void lru_carry_scan(const Frame& F) {
    float* LSUM = (float*)(F.ws + WS_LSUM); float* LCAR = LSUM + LCAR_OFF;
    for (int it = F.gw - F.NGW / 2; it < NSEQ * 2 * 8; it += F.NGW) { if (it < 0) continue;
        const int blk = it & 7, sd = it >> 3, dir = sd & 1; const int ch = blk * 64 + F.lane;
        float car = 0.f;
#pragma unroll 1
        for (int pb = 0; pb < LRU_NCH; pb += 16) { float a[16], h[16];
#pragma unroll
            for (int u = 0; u < 16; ++u) { const int p = pb + u, cq = dir ? LRU_NCH - 1 - p : p; const float* s = LSUM + ((size_t)(sd * LRU_NCH + cq) * 2) * 512 + ch; a[u] = s[0]; h[u] = s[512]; }
#pragma unroll
            for (int u = 0; u < 16; ++u) { const int p = pb + u, cq = dir ? LRU_NCH - 1 - p : p; LCAR[((size_t)(sd * LRU_NCH + cq)) * 512 + ch] = car; car = a[u] * car + h[u]; } }
    }
}

constexpr int CF_W = 0, CF_B = 63488, CF_G = 65536, CF_LB = 67584;
DI void conformer(const Frame& F, const float* dw_w  , const float* dw_b, const float* ln_g, const float* ln_b) {
    const bf16* P = (const bf16*)(F.ws + WS_U); bf16* Y = (bf16*)(F.ws + WS_H);
    LAS float* W = (LAS float*)(F.lds + CF_W); LAS float* B = (LAS float*)(F.lds + CF_B); LAS float* LG = (LAS float*)(F.lds + CF_G); LAS float* LB = (LAS float*)(F.lds + CF_LB);
    sync_threads();
    for (int i = F.tid; i < 31 * 512; i += NTHR) W[i] = dw_w[i];
    { B[F.tid] = dw_b[F.tid]; LG[F.tid] = ln_g[F.tid]; LB[F.tid] = ln_b[F.tid]; }
    sync_threads();
    const int c0 = F.lane * 8;
    for (int task = F.NGW - 1 - F.gw; task < NSEQ * (SEQ / 8); task += F.NGW) {
        const int seq = task / (SEQ / 8), t0 = (task % (SEQ / 8)) * 8; const size_t mrow0 = (size_t)seq * SEQ;
        f32x4 acc[8][2];
        { const f32x4 b0 = *(const LAS f32x4*)(B + c0), b1 = *(const LAS f32x4*)(B + c0 + 4);
#pragma unroll
          for (int tt = 0; tt < 8; ++tt) { acc[tt][0] = b0; acc[tt][1] = b1; } }
        f32x4 ww0[8], ww1[8];
#pragma unroll
        for (int s = 0; s < 8; ++s) { ww0[s] = (f32x4){0.f, 0.f, 0.f, 0.f}; ww1[s] = (f32x4){0.f, 0.f, 0.f, 0.f}; }
#pragma unroll 1
        for (int ib = 0; ib < 40; ib += 8) {
            v4u uw[8];
#pragma unroll
            for (int ii = 0; ii < 8; ++ii) { const int i = ib + ii, t = t0 - 15 + i; uw[ii] = (v4u){0u, 0u, 0u, 0u};
                if (i < 38 && t >= 0 && t < SEQ) uw[ii] = *(const v4u*)(P + (mrow0 + t) * NPC + P_CV + c0); }
#pragma unroll
            for (int ii = 0; ii < 8; ++ii) { const int i = ib + ii;
                ww0[ii] = (f32x4){0.f, 0.f, 0.f, 0.f}; ww1[ii] = (f32x4){0.f, 0.f, 0.f, 0.f};
                if (i <= 30) { ww0[ii] = *(const LAS f32x4*)(W + i * 512 + c0); ww1[ii] = *(const LAS f32x4*)(W + i * 512 + c0 + 4); }
                const f32x4 u0 = (f32x4){bflo(uw[ii].x), bfhi(uw[ii].x), bflo(uw[ii].y), bfhi(uw[ii].y)}, u1 = (f32x4){bflo(uw[ii].z), bfhi(uw[ii].z), bflo(uw[ii].w), bfhi(uw[ii].w)};
#pragma unroll
                for (int tt = 0; tt < 8; ++tt) { acc[tt][0] += ww0[(ii - tt) & 7] * u0; acc[tt][1] += ww1[(ii - tt) & 7] * u1; } }
        }
        float mean[8], rstd[8];
#pragma unroll
        for (int tt = 0; tt < 8; ++tt) mean[tt] = (acc[tt][0][0] + acc[tt][0][1]) + (acc[tt][0][2] + acc[tt][0][3]) + (acc[tt][1][0] + acc[tt][1][1]) + (acc[tt][1][2] + acc[tt][1][3]);
#pragma unroll
        for (int o = 1; o < 64; o <<= 1) { float t[8];
#pragma unroll
            for (int tt = 0; tt < 8; ++tt) t[tt] = shfl_xor_f(mean[tt], o);
#pragma unroll
            for (int tt = 0; tt < 8; ++tt) mean[tt] += t[tt]; }
#pragma unroll
        for (int tt = 0; tt < 8; ++tt) { mean[tt] *= (1.0f / 512.0f); const f32x4 d0 = acc[tt][0] - mean[tt], d1 = acc[tt][1] - mean[tt];
            rstd[tt] = (d0[0] * d0[0] + d0[1] * d0[1]) + (d0[2] * d0[2] + d0[3] * d0[3]) + (d1[0] * d1[0] + d1[1] * d1[1]) + (d1[2] * d1[2] + d1[3] * d1[3]); }
#pragma unroll
        for (int o = 1; o < 64; o <<= 1) { float t[8];
#pragma unroll
            for (int tt = 0; tt < 8; ++tt) t[tt] = shfl_xor_f(rstd[tt], o);
#pragma unroll
            for (int tt = 0; tt < 8; ++tt) rstd[tt] += t[tt]; }
        const f32x4 g0 = *(const LAS f32x4*)(LG + c0), g1 = *(const LAS f32x4*)(LG + c0 + 4), lb0 = *(const LAS f32x4*)(LB + c0), lb1 = *(const LAS f32x4*)(LB + c0 + 4);
#pragma unroll
        for (int tt = 0; tt < 8; ++tt) {
            const float rs = __builtin_amdgcn_rsqf(rstd[tt] * (1.0f / 512.0f) + EPS);
            const f32x4 d0 = acc[tt][0] - mean[tt], d1 = acc[tt][1] - mean[tt];
            const f32x4 y0 = d0 * rs * g0 + lb0, y1 = d1 * rs * g1 + lb1;
            v4u o; o.x = pk2(silu_f(y0[0]), silu_f(y0[1])); o.y = pk2(silu_f(y0[2]), silu_f(y0[3])); o.z = pk2(silu_f(y1[0]), silu_f(y1[1])); o.w = pk2(silu_f(y1[2]), silu_f(y1[3]));
            *(v4u*)(Y + (mrow0 + t0 + tt) * D + 1536 + c0) = o; }
    }
}
constexpr int NPH = 3 + NLAYER * 4 * 5;
static inline bool phase_exists(int p) { if (p < 3) return true; const int q = p - 3, it = (q / 5) % 4, slot = q % 5; if (slot == 0) return it == 0 || it == 3; if (slot >= 3) return it == 1; return true; }
#ifndef DUP_MASK
#define DUP_MASK 0
#endif
#ifndef DUP_SUB
#define DUP_SUB 15
#endif
#ifndef G_ALIGN
#define G_ALIGN true
#endif
#ifndef G_SP2
#define G_SP2 true
#endif
#ifndef WGM_BF
#define WGM_BF 8
#endif
#ifndef WGM_UP
#define WGM_UP 8
#endif
#ifndef MK_ONE_LAUNCH
#define MK_ONE_LAUNCH 1
#endif
struct Args { const float* in[28]; float* out; unsigned char* ws; int ph_lo, ph_hi, one_launch, pad; };
DI int opaque_i(int k) { asm volatile("" : "+s"(k)); return k; }
#define IN(k) (args.in[opaque_i(k)])
__global__ void __launch_bounds__(NTHR, 2) fwd_kernel(Args args) {
    extern __shared__ __attribute__((aligned(16))) unsigned char lds_raw[];
#define MKFRAME() Frame F; { int t_ = threadIdx.x; asm volatile("" : "+v"(t_)); unsigned char* w_ = args.ws; asm volatile("" : "+s"(w_)); float* o_ = args.out; asm volatile("" : "+s"(o_)); \
        F.lds = (LAS unsigned char*)lds_raw; F.tid = t_; F.lane = t_ & 63; F.wave = __builtin_amdgcn_readfirstlane(t_ >> 6); \
        F.bid = blockIdx.x; F.G = gridDim.x; F.gw = F.bid * NWAVES + F.wave; F.NGW = F.G * NWAVES; F.out = o_; F.ws = w_; }
    volatile LAS unsigned* MISC = (volatile LAS unsigned*)((LAS unsigned char*)lds_raw + MISC_OFF);
    if (threadIdx.x < 64) MISC[threadIdx.x] = 0u;
    sync_threads();
    unsigned* ctl = (unsigned*)(args.ws + WS_CTL);
    XcdBarrier bar; bar.bar = ctl + CW_BAR; bar.x = 0; bar.st = nullptr;
    if (args.one_launch) bar = xcd_barrier_post(ctl + CW_BAR, MISC + 8);
    const int lo = args.ph_lo, hi = args.ph_hi;
    bool need_bar = false;
#define RUN(p) (lo <= (p) && (p) < hi)
#define PRE_BAR() do { if (need_bar) xcd_barrier(bar); need_bar = (args.one_launch != 0); } while (0)
#define PREMUL ((const float*)(F.ws + WS_VEC))
#define PREADD (PREMUL + VEC_ELEMS)
#define POSTMUL (PREMUL + 2 * VEC_ELEMS)
#define Hb ((bf16*)(F.ws + WS_H))
#define Ub ((bf16*)(F.ws + WS_U))
#define Gb ((bf16*)(F.ws + WS_G))

    if (RUN(0)) { PRE_BAR(); MKFRAME();
        ProArgs A{IN(2), IN(3), IN(4), IN(8), IN(9), IN(10), IN(11), IN(12), IN(27), IN(18), IN(20), IN(22), IN(13)};
        prologue_a(F, A); }
    if (RUN(1)) { PRE_BAR(); MKFRAME(); prologue_b(F, IN(5), IN(6), IN(7)); }
    if (RUN(2)) { PRE_BAR(); MKFRAME(); const X16 xn{nullptr, nullptr, 0}; norm_rows<false, 0, 0, true>(F, IN(0), IN(1), xn, xn, F.out, nullptr, Hb, nullptr, PREMUL, PREADD); }

    int dup = 0;
#pragma unroll 1
    for (int li = 0; li < NLAYER * 4; ++li) {
        const int l = li >> 2, it = li & 3, base = 3 + li * 5;
        const bool dp = DUP_MASK != 0 && dup != 0;
#define SLOT_ON(s) (!dp || ((DUP_MASK >> (s)) & 1))
#ifdef SKIP_MIX
        if (it == 1 || it == 2) continue;
#endif
        if ((it == 0 || it == 3) && RUN(base) && SLOT_ON(0)) { PRE_BAR(); MKFRAME();
            const int f = it == 3;
            pg8::Gemm g{Hb, (const bf16*)(F.ws + WS_WUP) + (size_t)(l * 2 + f) * NUP * D, M, NUP, D}; pg8::StaticOrder S; S.init(M, NUP, F.G, F.bid, WGM_UP);
            pg8::EpiSwiGLU E{Ub, DFF};
#if defined(EXP_SAMETILE)
            if (dp) { pg8::SameTileOrder S2; S2.init(M, NUP, F.G, F.bid); pg8::gemm_phase<pg8::EpiSwiGLU, pg8::SameTileOrder, true, true>(F.lds, g, S2, E, F.tid); } else
#endif
            pg8::gemm_phase<pg8::EpiSwiGLU, pg8::StaticOrder, G_ALIGN, G_SP2>(F.lds, g, S, E, F.tid); }
        if (RUN(base + 1) && SLOT_ON(1)) { PRE_BAR(); MKFRAME();
            pg8::Gemm g; pg8::EpiBf16 E;
            if (it == 1) { g = pg8::Gemm{Hb, (const bf16*)(F.ws + WS_WMI) + (size_t)l * NPC * D, M, NPC, D}; E = pg8::EpiBf16{Ub, NPC, 1}; }
            else if (it == 2) { g = pg8::Gemm{Hb, (const bf16*)(F.ws + WS_WMO) + (size_t)l * D * D, M, D, D}; E = pg8::EpiBf16{Gb, D, 0}; }
            else { g = pg8::Gemm{Ub, (const bf16*)(F.ws + WS_WDN) + (size_t)(l * 2 + (it == 3)) * D * DFF, M, D, DFF}; E = pg8::EpiBf16{Gb, D, 0}; }
            pg8::StaticOrder S; S.init(g.M, g.N, F.G, F.bid, WGM_BF);
#if defined(EXP_SAMETILE2)
            if (dp) { pg8::SameTileOrder S2; S2.init(g.M, g.N, F.G, F.bid); pg8::gemm_phase<pg8::EpiBf16, pg8::SameTileOrder, G_ALIGN, G_SP2>(F.lds, g, S2, E, F.tid); } else
#endif
            pg8::gemm_phase<pg8::EpiBf16, pg8::StaticOrder, G_ALIGN, G_SP2>(F.lds, g, S, E, F.tid); }
        if (it == 1) {
            if (RUN(base + 2) && SLOT_ON(2)) { PRE_BAR(); MKFRAME();
                if (!dp || (DUP_SUB & 1)) fourier_a(F);
                if (dp && (DUP_SUB & 16)) gla_g1<1>(F, (const v4u*)(F.ws + WS_SMALL + SM_WAF) + (size_t)l * 2 * 4 * 4 * 2 * 64, IN(14) + (size_t)l * 2 * 256);
                if (dp && (DUP_SUB & 64)) gla_g1<3>(F, (const v4u*)(F.ws + WS_SMALL + SM_WAF) + (size_t)l * 2 * 4 * 4 * 2 * 64, IN(14) + (size_t)l * 2 * 256);
                if (dp && (DUP_SUB & 32)) gla_g1<2>(F, (const v4u*)(F.ws + WS_SMALL + SM_WAF) + (size_t)l * 2 * 4 * 4 * 2 * 64, IN(14) + (size_t)l * 2 * 256);
                if (!dp || (DUP_SUB & 2)) gla_g1(F, (const v4u*)(F.ws + WS_SMALL + SM_WAF) + (size_t)l * 2 * 4 * 4 * 2 * 64, IN(14) + (size_t)l * 2 * 256);
                LruArgs LA{IN(16) + (size_t)l * 2 * 4 * 512, IN(17) + (size_t)l * 2 * 512, IN(19) + (size_t)l * 2 * 512, IN(21) + (size_t)l * 2 * 512};
                if (!dp || (DUP_SUB & 4)) lru_pass<false>(F, LA, l);
                if (dp && (DUP_SUB & 128)) lru_pass<false, 1>(F, LA, l);
                if (dp && (DUP_SUB & 256)) lru_pass<false, 2>(F, LA, l);
                if (dp && (DUP_SUB & 512)) lru_pass<false, 3>(F, LA, l);
                sync_threads();
                if (!dp || (DUP_SUB & 8)) conformer(F, IN(23) + (size_t)l * 31 * 512, IN(24) + (size_t)l * 512, IN(25) + (size_t)l * 512, IN(26) + (size_t)l * 512); }
            if (RUN(base + 3) && SLOT_ON(3)) { PRE_BAR(); MKFRAME();
                if (!dp || (DUP_SUB & 1)) fourier_b(F);
                if (!dp) gla_g2(F);
                lru_carry_scan(F); }
            if (RUN(base + 4) && SLOT_ON(4)) { PRE_BAR(); MKFRAME();
                if (!dp || (DUP_SUB & 2)) gla_g3(F, IN(15) + (size_t)l * 128);
                LruArgs LA{IN(16) + (size_t)l * 2 * 4 * 512, IN(17) + (size_t)l * 2 * 512, IN(19) + (size_t)l * 2 * 512, IN(21) + (size_t)l * 2 * 512};
                if (!dp || (DUP_SUB & 4)) { sync_threads(); lru_out(F); } }
        } else if (RUN(base + 2) && (!dp || ((DUP_MASK >> 5) & 1))) { PRE_BAR(); MKFRAME();
            const int j = it == 0 ? 0 : (it == 2 ? 1 : 2); const int lj = l * 3 + j;
            const float* pm = POSTMUL + (size_t)lj * NSEQ * D;
            const float* nm = PREMUL + (size_t)(lj + 1) * NSEQ * D; const float* na = PREADD + (size_t)(lj + 1) * NSEQ * D;
            const float ps = dp ? 0.f : 1.f;
            const X16 xa{(bf16*)F.out, (bf16*)F.out + (size_t)X16_SPLIT * D, X16_SPLIT}; const X16 xb{(bf16*)(F.ws + WS_WUP), (bf16*)(F.ws + WS_LS), X16_SPLIT};
            if (li == 0 && !dp) norm_rows<true, 0, 1, true>(F, IN(0), IN(1), xa, xa, F.out, Gb, Hb, pm, nm, na);
            else if (li == NLAYER * 4 - 1) norm_rows<true, 1, 2, false>(F, nullptr, nullptr, xb, xb, F.out, Gb, Hb, pm, nullptr, nullptr, ps);
            else if (li == NLAYER * 4 - 2) norm_rows<true, 1, 1, true>(F, nullptr, nullptr, xa, xb, F.out, Gb, Hb, pm, nm, na, ps);
            else norm_rows<true, 1, 1, true>(F, nullptr, nullptr, xa, xa, F.out, Gb, Hb, pm, nm, na, ps); }
#if defined(EXP_BARS)
        if (dp && args.one_launch) { for (int q = 0; q < EXP_BARS; ++q) xcd_barrier(bar); }
#endif
        if (DUP_MASK != 0) { if (!dp) { dup = 1; --li; } else dup = 0; }
    }
#undef SLOT_ON
#undef RUN
#undef PRE_BAR
}

extern "C" void kernel_launch(void* const* d_in, const int* in_sizes, int n_in, void* d_out, int out_size, void* d_ws, size_t ws_size, hipStream_t stream) {
    static int grid = 0;
    if (grid == 0) {
        if (n_in != 28 || out_size != M * D || ws_size < WS_END) { fprintf(stderr, "kernel_launch: unexpected problem (n_in %d, out %d, ws %zu)\n", n_in, out_size, ws_size); grid = -1; return; }
        int dev = 0, cus = 0;
        if (hipGetDevice(&dev) != hipSuccess || hipDeviceGetAttribute(&cus, hipDeviceAttributeMultiprocessorCount, dev) != hipSuccess) { grid = -1; return; }
        if (hipFuncSetAttribute((const void*)fwd_kernel, hipFuncAttributeMaxDynamicSharedMemorySize, LDS_BYTES) != hipSuccess) { fprintf(stderr, "kernel_launch: hipFuncSetAttribute failed\n"); grid = -1; return; }
        int per_cu = 0;
        if (hipOccupancyMaxActiveBlocksPerMultiprocessor(&per_cu, (const void*)fwd_kernel, NTHR, LDS_BYTES) != hipSuccess || per_cu < 1) { fprintf(stderr, "kernel_launch: occupancy query says %d\n", per_cu); }
        (void)hipGetLastError();
        grid = cus;
    }
    if (grid < 0) return;
    (void)hipMemsetAsync((char*)d_ws + WS_CTL, 0, CTL_ZERO_BYTES, stream);
    Args a{};
    for (int i = 0; i < 28; ++i) a.in[i] = (const float*)d_in[i];
    a.out = (float*)d_out; a.ws = (unsigned char*)d_ws; a.pad = 0;
#if MK_ONE_LAUNCH
    a.ph_lo = 0; a.ph_hi = NPH; a.one_launch = 1;
    hipLaunchKernelGGL(fwd_kernel, dim3(grid), dim3(NTHR), LDS_BYTES, stream, a);
#else
    a.one_launch = 0;
    for (int p = 0; p < NPH; ++p) { if (!phase_exists(p)) continue; a.ph_lo = p; a.ph_hi = p + 1;
        hipLaunchKernelGGL(fwd_kernel, dim3(grid), dim3(NTHR), LDS_BYTES, stream, a); }
#endif
}
```
